# Optimizing an MI355X kernel written in HIP

```python
import math
import jax, jax.numpy as jnp
from jax import lax
import numpy as np

D_MODEL = 1024
BATCH = 8
SEQ = 4096
DEPTH = 1

SSM_GROUP = 16
SSM_GROUPS = 32
SSM_WIDTH = SSM_GROUP * SSM_GROUPS
SSM_STATE = 64
SSM_DT_MIN = 0.001
SSM_DT_MAX = 0.1
MLA_HEADS = 8
MLA_QK_NOPE = 64
MLA_QK_ROPE = 32
MLA_V = 64
MLA_Q_LORA = 256
MLA_KV_LORA = 128
MLA_WIDTH = MLA_HEADS * MLA_V
ROPE_THETA = 10000.0
Q_BLOCK = 128
N_MEM = 256
MEM_HEADS = 4
MEM_HEAD_DIM = 128
MEM_WIDTH = MEM_HEADS * MEM_HEAD_DIM
N_BRANCH = 3
NORM_EPS = 1e-6
IN_SPLITS = (SSM_WIDTH, SSM_WIDTH, MLA_Q_LORA, MLA_KV_LORA, MLA_QK_ROPE, MLA_WIDTH,
             MEM_WIDTH, MEM_WIDTH, N_BRANCH * D_MODEL)
IN_WIDTH = 6048

kernel_name = 'hybrid_s5_mla_memory_gated_block'


def rms_norm(x, g):
    xf = x.astype(jnp.float32)
    xf = xf * lax.rsqrt(jnp.mean(xf * xf, axis=-1, keepdims=True) + NORM_EPS)
    return xf.astype(x.dtype) * g


def split_columns(t):
    parts, start = [], 0
    for w in IN_SPLITS:
        parts.append(t[..., start:start + w])
        start += w
    return parts


def rope_tables(positions):
    inv_freq = ROPE_THETA ** (-jnp.arange(0, MLA_QK_ROPE, 2, dtype=jnp.float32) / MLA_QK_ROPE)
    ang = positions.astype(jnp.float32)[..., None] * inv_freq
    return jnp.cos(ang), jnp.sin(ang)


def apply_rope(t, cos, sin):
    cos = cos.astype(t.dtype)
    sin = sin.astype(t.dtype)
    t1, t2 = jnp.split(t, 2, axis=-1)
    return jnp.concatenate([t1 * cos - t2 * sin, t2 * cos + t1 * sin], axis=-1)


def _complex_linear_combine(e1, e2):
    a1r, a1i, b1r, b1i = e1
    a2r, a2i, b2r, b2i = e2
    ar = a2r * a1r - a2i * a1i
    ai = a2r * a1i + a2i * a1r
    br = a2r * b1r - a2i * b1i + b2r
    bi = a2r * b1i + a2i * b1r + b2i
    return (ar, ai, br, bi)


def s5_direction(u_g, lam_re, lam_im, log_dt, b_re, b_im, c_re, c_im, reverse):
    seq_len = u_g.shape[1]
    dt = jnp.exp(log_dt)[:, None]
    decay = jnp.exp(lam_re * dt)
    a_re = decay * jnp.cos(lam_im * dt)
    a_im = decay * jnp.sin(lam_im * dt)
    denom = lam_re * lam_re + lam_im * lam_im
    f_re = a_re - 1.0
    z_re = (f_re * lam_re + a_im * lam_im) / denom
    z_im = (a_im * lam_re - f_re * lam_im) / denom
    bb_re = z_re[..., None] * b_re - z_im[..., None] * b_im
    bb_im = z_re[..., None] * b_im + z_im[..., None] * b_re
    bu_re = jnp.einsum('blgp,gnp->blgn', u_g, bb_re)
    bu_im = jnp.einsum('blgp,gnp->blgn', u_g, bb_im)
    a_re_t = jnp.broadcast_to(a_re[None, None], (1, seq_len) + a_re.shape)
    a_im_t = jnp.broadcast_to(a_im[None, None], (1, seq_len) + a_im.shape)
    _, _, s_re, s_im = lax.associative_scan(
        _complex_linear_combine, (a_re_t, a_im_t, bu_re, bu_im), reverse=reverse, axis=1)
    return jnp.einsum('blgn,gpn->blgp', s_re, c_re) - jnp.einsum('blgn,gpn->blgp', s_im, c_im)


def s5_branch(u, lam_re, lam_im, log_dt, b_re, b_im, c_re, c_im, d_skip, glu_w, glu_b):
    bsz, seq_len, _ = u.shape
    u_g = u.reshape(bsz, seq_len, SSM_GROUPS, SSM_GROUP)
    y = d_skip * u
    for direction in range(2):
        y = y + s5_direction(u_g, lam_re[direction], lam_im[direction], log_dt[direction],
                             b_re[direction], b_im[direction], c_re[direction], c_im[direction],
                             reverse=(direction == 1)).reshape(bsz, seq_len, SSM_WIDTH)
    y = jax.nn.gelu(y)
    return y * jax.nn.sigmoid(y @ glu_w + glu_b)


def mla_branch(c_q, c_kv, k_rope, cos, sin, q_norm, w_q_up, kv_norm, w_kv_up):
    bsz, seq_len, _ = c_q.shape
    q = (rms_norm(c_q, q_norm) @ w_q_up).reshape(bsz, seq_len, MLA_HEADS, MLA_QK_NOPE + MLA_QK_ROPE)
    q_nope = q[..., :MLA_QK_NOPE]
    q_rope = apply_rope(q[..., MLA_QK_NOPE:], cos[:, :, None, :], sin[:, :, None, :])
    kv = (rms_norm(c_kv, kv_norm) @ w_kv_up).reshape(bsz, seq_len, MLA_HEADS, MLA_QK_NOPE + MLA_V)
    k_nope = kv[..., :MLA_QK_NOPE]
    v = kv[..., MLA_QK_NOPE:]
    k_rope = apply_rope(k_rope, cos, sin)
    scale = (MLA_QK_NOPE + MLA_QK_ROPE) ** -0.5
    n_blk = seq_len // Q_BLOCK

    def blocks(t):
        return t.reshape((bsz, n_blk, Q_BLOCK) + t.shape[2:]).swapaxes(0, 1)

    def attend(qb):
        qn, qr = qb
        s = jnp.einsum('bqhd,bkhd->bhqk', qn, k_nope) + jnp.einsum('bqhr,bkr->bhqk', qr, k_rope)
        p = jax.nn.softmax(s.astype(jnp.float32) * scale, axis=-1).astype(v.dtype)
        return jnp.einsum('bhqk,bkhd->bqhd', p, v)

    o = lax.map(attend, (blocks(q_nope), blocks(q_rope)))
    return o.swapaxes(0, 1).reshape(bsz, seq_len, MLA_WIDTH)


def memory_branch(q_mem, mem, mem_norm, mem_w_kv):
    bsz, seq_len, _ = q_mem.shape
    n_mem = mem.shape[1]
    kv = (rms_norm(mem, mem_norm) @ mem_w_kv).reshape(bsz, n_mem, 2, MEM_HEADS, MEM_HEAD_DIM)
    k, v = kv[:, :, 0], kv[:, :, 1]
    q = q_mem.reshape(bsz, seq_len, MEM_HEADS, MEM_HEAD_DIM)
    s = jnp.einsum('blhd,bmhd->bhlm', q, k).astype(jnp.float32) * (MEM_HEAD_DIM ** -0.5)
    p = jax.nn.softmax(s, axis=-1).astype(v.dtype)
    return jnp.einsum('bhlm,bmhd->blhd', p, v).reshape(bsz, seq_len, MEM_WIDTH)


def setup_inputs(seed: int = 0) -> dict:
    key = jax.random.key(seed)
    ks = jax.random.split(key, 32)
    f32 = jnp.float32

    def nrm(k, shape, scale):
        return jax.random.normal(k, shape, f32) * scale

    nl = DEPTH
    G, N, P = SSM_GROUPS, SSM_STATE, SSM_GROUP
    x = nrm(ks[0], (BATCH, SEQ, D_MODEL), 1.0)
    mem = nrm(ks[1], (BATCH, N_MEM, D_MODEL), 1.0)
    positions = (jnp.arange(SEQ, dtype=jnp.int32)[None, :]
                 + jax.random.randint(ks[2], (BATCH, 1), 0, 1024, dtype=jnp.int32))
    pre_norm = 1.0 + nrm(ks[3], (nl, D_MODEL), 0.05)
    w_in = nrm(ks[4], (nl, D_MODEL, IN_WIDTH), D_MODEL ** -0.5)
    b_gate = nrm(ks[5], (nl, N_BRANCH * D_MODEL), 0.01)
    ssm_lambda_re = -0.5 + nrm(ks[6], (nl, 2, G, N), 0.01)
    ssm_lambda_im = math.pi * jnp.arange(N, dtype=f32) + nrm(ks[7], (nl, 2, G, N), 0.01)
    ssm_log_dt = jax.random.uniform(ks[8], (nl, 2, G), f32,
                                    math.log(SSM_DT_MIN), math.log(SSM_DT_MAX))
    ssm_b_re = nrm(ks[9], (nl, 2, G, N, P), (2 * P) ** -0.5)
    ssm_b_im = nrm(ks[10], (nl, 2, G, N, P), (2 * P) ** -0.5)
    ssm_c_re = nrm(ks[11], (nl, 2, G, P, N), N ** -0.5)
    ssm_c_im = nrm(ks[12], (nl, 2, G, P, N), N ** -0.5)
    ssm_d = nrm(ks[13], (nl, SSM_WIDTH), 1.0)
    ssm_glu_w = nrm(ks[14], (nl, SSM_WIDTH, SSM_WIDTH), SSM_WIDTH ** -0.5)
    ssm_glu_b = nrm(ks[15], (nl, SSM_WIDTH), 0.01)
    mla_q_norm = 1.0 + nrm(ks[16], (nl, MLA_Q_LORA), 0.05)
    mla_w_q_up = nrm(ks[17], (nl, MLA_Q_LORA, MLA_HEADS * (MLA_QK_NOPE + MLA_QK_ROPE)), MLA_Q_LORA ** -0.5)
    mla_kv_norm = 1.0 + nrm(ks[18], (nl, MLA_KV_LORA), 0.05)
    mla_w_kv_up = nrm(ks[19], (nl, MLA_KV_LORA, MLA_HEADS * (MLA_QK_NOPE + MLA_V)), MLA_KV_LORA ** -0.5)
    mem_norm = 1.0 + nrm(ks[20], (nl, D_MODEL), 0.05)
    mem_w_kv = nrm(ks[21], (nl, D_MODEL, 2 * MEM_WIDTH), D_MODEL ** -0.5)
    w_branch_ssm = nrm(ks[22], (nl, SSM_WIDTH, D_MODEL), SSM_WIDTH ** -0.5)
    w_branch_mla = nrm(ks[23], (nl, MLA_WIDTH, D_MODEL), MLA_WIDTH ** -0.5)
    w_branch_mem = nrm(ks[24], (nl, MEM_WIDTH, D_MODEL), MEM_WIDTH ** -0.5)
    w_out = nrm(ks[25], (nl, D_MODEL, D_MODEL), D_MODEL ** -0.5)
    post_norm = 1.0 + nrm(ks[26], (nl, D_MODEL), 0.05)
    return {'x': x, 'mem': mem, 'positions': positions, 'pre_norm': pre_norm, 'w_in': w_in,
            'b_gate': b_gate, 'ssm_lambda_re': ssm_lambda_re, 'ssm_lambda_im': ssm_lambda_im,
            'ssm_log_dt': ssm_log_dt, 'ssm_b_re': ssm_b_re, 'ssm_b_im': ssm_b_im,
            'ssm_c_re': ssm_c_re, 'ssm_c_im': ssm_c_im, 'ssm_d': ssm_d, 'ssm_glu_w': ssm_glu_w,
            'ssm_glu_b': ssm_glu_b, 'mla_q_norm': mla_q_norm, 'mla_w_q_up': mla_w_q_up,
            'mla_kv_norm': mla_kv_norm, 'mla_w_kv_up': mla_w_kv_up, 'mem_norm': mem_norm,
            'mem_w_kv': mem_w_kv, 'w_branch_ssm': w_branch_ssm, 'w_branch_mla': w_branch_mla,
            'w_branch_mem': w_branch_mem, 'w_out': w_out, 'post_norm': post_norm}


def reference(x, mem, positions, pre_norm, w_in, b_gate, ssm_lambda_re, ssm_lambda_im,
              ssm_log_dt, ssm_b_re, ssm_b_im, ssm_c_re, ssm_c_im, ssm_d, ssm_glu_w,
              ssm_glu_b, mla_q_norm, mla_w_q_up, mla_kv_norm, mla_w_kv_up, mem_norm,
              mem_w_kv, w_branch_ssm, w_branch_mla, w_branch_mem, w_out, post_norm):
    bsz, seq_len, _ = x.shape
    cos, sin = rope_tables(positions)
    for l in range(DEPTH):
        h = rms_norm(x, pre_norm[l])
        proj = jnp.einsum('bld,dc->blc', h, w_in[l])
        u_ssm, z_ssm, c_q, c_kv, k_rope, z_mla, q_mem, z_mem, gate_logits = split_columns(proj)
        y_ssm = s5_branch(u_ssm, ssm_lambda_re[l], ssm_lambda_im[l], ssm_log_dt[l],
                          ssm_b_re[l], ssm_b_im[l], ssm_c_re[l], ssm_c_im[l],
                          ssm_d[l], ssm_glu_w[l], ssm_glu_b[l])
        y_mla = mla_branch(c_q, c_kv, k_rope, cos, sin, mla_q_norm[l], mla_w_q_up[l],
                           mla_kv_norm[l], mla_w_kv_up[l])
        y_mem = memory_branch(q_mem, mem, mem_norm[l], mem_w_kv[l])
        gates = jax.nn.sigmoid(gate_logits + b_gate[l]).reshape(bsz, seq_len, N_BRANCH, D_MODEL)
        merged = (gates[:, :, 0] * ((jax.nn.silu(z_ssm) * y_ssm) @ w_branch_ssm[l])
                  + gates[:, :, 1] * ((jax.nn.silu(z_mla) * y_mla) @ w_branch_mla[l])
                  + gates[:, :, 2] * ((jax.nn.silu(z_mem) * y_mem) @ w_branch_mem[l]))
        out = merged @ w_out[l]
        x = x + rms_norm(out, post_norm[l])
    return x
```

```cpp
#include <hip/hip_runtime.h>
#include <hip/hip_cooperative_groups.h>
#include <cstdio>
#include <cstdint>
namespace cg = cooperative_groups;

#define LAS __attribute__((address_space(3)))
#define GAS __attribute__((address_space(1)))
typedef unsigned short bf16_t;
typedef short bf16x8 __attribute__((ext_vector_type(8)));
typedef float f32x4 __attribute__((ext_vector_type(4)));
typedef float f32x16 __attribute__((ext_vector_type(16)));
typedef unsigned u32x4 __attribute__((ext_vector_type(4)));
typedef unsigned u32x2 __attribute__((ext_vector_type(2)));

constexpr int TOK = 32768, DM = 1024, SEQ = 4096, NB = 8;
constexpr int NPROJ = 6144;
constexpr int PW = 5120;
constexpr int PC_ZSSM = 0, PC_ZMLA = 512, PC_ZMEM = 1024, PC_QMEM = 1536, PC_GATE = 2048;
constexpr float LOG2E = 1.4426950408889634f;
constexpr float NORM_EPS = 1e-6f;

constexpr size_t MiB = 1u << 20;
constexpr size_t WS_WIN = 0;
constexpr size_t WS_WGLU = 12 * MiB;
constexpr size_t WS_WQ = WS_WGLU + 512 * 1024;
constexpr size_t WS_WK = WS_WQ + 384 * 1024;
constexpr size_t WS_WV = WS_WK + 128 * 1024;
constexpr size_t WS_WMK = 14 * MiB;
constexpr size_t WS_WMV = 15 * MiB;
constexpr size_t WS_WBR = 16 * MiB;
constexpr size_t WS_WOUT = 19 * MiB;
constexpr size_t WS_MET = 21 * MiB;
constexpr size_t WS_MYT = 25 * MiB;
constexpr size_t WS_COS = 33 * MiB;
constexpr size_t WS_SIN = 35 * MiB;
constexpr size_t WS_APOW = 37 * MiB;
constexpr size_t WS_BBAR = 38 * MiB;
constexpr size_t WS_KT = 39 * MiB;
constexpr size_t WS_KMEM = 40 * MiB;
constexpr size_t WS_VTMEM = 42 * MiB;
constexpr size_t WS_CTL = 44 * MiB, CTL_BYTES = 16384;
constexpr size_t WS_P = 48 * MiB;
constexpr size_t WS_CQR = 368 * MiB;
constexpr size_t WS_VT = WS_CQR;
constexpr size_t WS_AP = 400 * MiB;
constexpr size_t WS_OUT = WS_P;
constexpr size_t WS_MG = 368 * MiB;
constexpr size_t WS_CQN = 464 * MiB;
constexpr size_t WS_CKVN = 0;
constexpr size_t WS_Y = 480 * MiB;
constexpr size_t WS_END = 512 * MiB;
constexpr size_t DO_H = 0;
constexpr size_t DO_MEMN = 64 * MiB;
constexpr size_t DO_E = 0;
constexpr size_t DO_KBUF = 32 * MiB;
constexpr size_t DO_QB = 80 * MiB;
constexpr size_t DO_Y = 0;
constexpr size_t DO_MERGED = 0;

__device__ __forceinline__ unsigned pk2(float lo, float hi) {
    typedef float f2 __attribute__((ext_vector_type(2))); typedef __bf16 b2 __attribute__((ext_vector_type(2)));
    f2 v = {lo, hi}; b2 b = __builtin_convertvector(v, b2); return __builtin_bit_cast(unsigned, b);
}
__device__ __forceinline__ float bf_lo(unsigned w) { return __uint_as_float(w << 16); }
__device__ __forceinline__ float bf_hi(unsigned w) { return __uint_as_float(w & 0xffff0000u); }
__device__ __forceinline__ float bf2f(bf16_t h) { return __uint_as_float((unsigned)h << 16); }
__device__ __forceinline__ float fexp2(float x) { return __builtin_amdgcn_exp2f(x); }
__device__ __forceinline__ float frcp(float x) { return __builtin_amdgcn_rcpf(x); }
__device__ __forceinline__ float sigmoidf_(float x) { return frcp(1.f + fexp2(-x * LOG2E)); }
__device__ __forceinline__ float siluf_(float x) { return x * sigmoidf_(x); }
__device__ __forceinline__ float gelu_tanh(float x) { const float u = 0.7978845608028654f * (x + 0.044715f * x * x * x); return x * sigmoidf_(2.f * u); }
__device__ __forceinline__ int lane_id_() { return (int)__builtin_amdgcn_mbcnt_hi(~0u, __builtin_amdgcn_mbcnt_lo(~0u, 0u)); }
__device__ __forceinline__ float wave_sum(float v) {
#pragma unroll
    for (int o = 1; o < 64; o <<= 1) v += __shfl_xor(v, o);
    return v;
}
__device__ __forceinline__ void sincos_red(double ang, float& s, float& c) {
    const double k = rint(ang * 0.15915494309189535);
    const float r = (float)(ang - k * 6.283185307179586);
    s = sinf(r); c = cosf(r);
}

namespace pg8 {
constexpr int BM = 256, BK = 64, HALF = 128, HTB = HALF * BK * 2, STAGE_BYTES = 8 * HTB, NXCD = 8, WGM = 8;
__host__ __device__ __forceinline__ int lds_byte(int r, int c) { const int st = (r >> 4) * 2 + (c >> 5), rr = r & 15, cc = c & 31, ob = rr * 64 + cc * 2; return st * 1024 + (ob ^ (((ob >> 9) & 1) << 5)); }
__host__ __device__ __forceinline__ void stage_rc(int b, int& R, int& C) { const int st = b / 1024, sb = b % 1024, swz = sb ^ (((sb >> 9) & 1) << 5); R = (st >> 1) * 16 + swz / 64; C = (st & 1) * 32 + (swz % 64) / 2; }
__host__ __device__ __forceinline__ int perm32(int rho) { const int n = rho >> 4, i = rho & 15; return 8 * (i >> 2) + 4 * n + (i & 3); }

struct Unit { int pm, pn, aux, pad_; size_t aoff, boff; };
struct Gemm { const GAS bf16_t* A; const GAS bf16_t* Bt; int lda, ldb, K; };

__device__ __forceinline__ bool tile_order(long L, int nM, int nN, int& pm, int& pn) {
    const int nwg = nM * nN; if (L >= nwg) return false;
    int wgid = (int)L; { const int q = nwg / NXCD, r = nwg % NXCD, xcd = wgid % NXCD, off = wgid / NXCD; wgid = (xcd < r ? xcd * (q + 1) : r * (q + 1) + (xcd - r) * q) + off; }
    const int nig = WGM * nN, gid = wgid / nig, fm = gid * WGM, gsz = (nM - fm) < WGM ? (nM - fm) : WGM;
    pm = fm + ((wgid % nig) % gsz); pn = (wgid % nig) / gsz; return true;
}
struct SchedPlain {
    int nM, nN, G, c; size_t astep, bstep;
    __device__ __forceinline__ bool next(int i, Unit& u) const {
        if (!tile_order((long)i * G + c, nM, nN, u.pm, u.pn)) return false;
        u.aux = 0; u.pad_ = 0; u.aoff = (size_t)u.pm * astep; u.boff = (size_t)u.pn * bstep; return true; }
};
struct SchedBatch8 {
    int nM, G, c; size_t astep, bstep;
    __device__ __forceinline__ bool next(int i, Unit& u) const {
        const long L = (long)i * G + c; if (L >= nM) return false;
        u.pm = (int)L; u.pn = 0; u.aux = 0; u.pad_ = 0; u.aoff = (size_t)u.pm * astep; u.boff = (size_t)(u.pm >> 3) * bstep; return true; }
};
struct SchedPair {
    int c; size_t astep, bstep;
    __device__ __forceinline__ bool next(int i, Unit& u) const {
        if (i >= 2) return false;
        u.pm = c >> 1; u.pn = 2 * (c & 1) + i; u.aux = i; u.pad_ = 0; u.aoff = (size_t)u.pm * astep; u.boff = (size_t)u.pn * bstep; return true; }
};
struct SchedBranch {
    int nM, nN, G, c; size_t astep, bstep;
    __device__ __forceinline__ bool next(int i, Unit& u) const {
        const int seg = i % 3, it = i / 3;
        if (!tile_order((long)it * G + c, nM, nN, u.pm, u.pn)) return false;
        u.aux = seg; u.pad_ = 0; u.aoff = (size_t)u.pm * astep + (size_t)(seg == 0 ? PC_ZSSM * 2 : (seg == 1 ? PC_ZMLA * 2 : PC_ZMEM * 2)); u.boff = (size_t)(seg * nN + u.pn) * bstep; return true; }
};

template <class Epi, class Sched>
__device__ __forceinline__ void gemm_phase(LAS unsigned char* lds, const Gemm g, const Sched& S, const Epi& E, const int wave_) {
    int lane_ = lane_id_(); asm volatile("" : "+v"(lane_));
    const int lane = lane_, wid = wave_, tid = wave_ * 64 + lane, wr = wid >> 2, wc = wid & 3, fr = lane & 15, fq = lane >> 4;
    int K_ = g.K; asm volatile("" : "+s"(K_));
    const int K = K_, nt = K / BK;
    unsigned voffA[2], voffB[2];
#pragma unroll
    for (int i = 0; i < 2; ++i) { int R, C; stage_rc(tid * 16 + i * 8192, R, C); const int Rb = Epi::PERM ? ((R & ~31) + perm32(R & 31)) : R;
        voffA[i] = (unsigned)(R * g.lda + C) * 2u; voffB[i] = (unsigned)(Rb * g.ldb + C) * 2u; }
    const size_t kstep = (size_t)(BK * 2);
    const size_t hstepA = (size_t)HALF * g.lda * 2, hstepB = (size_t)HALF * g.ldb * 2;
    const unsigned ldsw = (unsigned)wid * 1024u;
    const int aoff = lds_byte(wr * 64 + fr, fq * 8), boff = lds_byte(wc * 32 + fr, fq * 8);
#define PG8_SA(b, h) (((b) * 2 + (h)) * HTB)
#define PG8_SB(b, h) ((4 + (b) * 2 + (h)) * HTB)
#define PG8_STAGE(bufoff, gbase, voff) do { _Pragma("unroll") for (int _i = 0; _i < 2; ++_i) \
        __builtin_amdgcn_global_load_lds((const GAS unsigned*)((const char*)(gbase) + (voff)[_i]), (LAS unsigned*)(lds + (bufoff) + ldsw + _i * 8192), 16, 0, 0); } while (0)
#define PG8_LDA(dst, b, h) do { _Pragma("unroll") for (int m = 0; m < 4; ++m) _Pragma("unroll") for (int k = 0; k < 2; ++k) dst[m][k] = *(const LAS bf16x8*)(lds + PG8_SA(b, h) + aoff + m * 2048 + k * 1024); } while (0)
#define PG8_LDB(dst, b, h) do { _Pragma("unroll") for (int n = 0; n < 2; ++n) _Pragma("unroll") for (int k = 0; k < 2; ++k) dst[n][k] = *(const LAS bf16x8*)(lds + PG8_SB(b, h) + boff + n * 2048 + k * 1024); } while (0)
#define PG8_MMA(ai, bj, At, Bt) do { __builtin_amdgcn_s_setprio(1); _Pragma("unroll") for (int m = 0; m < 4; ++m) _Pragma("unroll") for (int n = 0; n < 2; ++n) _Pragma("unroll") for (int k = 0; k < 2; ++k) \
        acc[ai][bj][m][n] = __builtin_amdgcn_mfma_f32_16x16x32_bf16(Bt[n][k], At[m][k], acc[ai][bj][m][n], 0, 0, 0); __builtin_amdgcn_s_setprio(0); } while (0)
#define PG8_WAIT_V(n) asm volatile("s_waitcnt vmcnt(" #n ")" ::: "memory")
#define PG8_WAIT_L(n) asm volatile("s_waitcnt lgkmcnt(" #n ")" ::: "memory")
#define PG8_BAR __builtin_amdgcn_s_barrier()
#define PG8_SCHED __builtin_amdgcn_sched_barrier(0)
    Unit cur, nxt; int ui = 0;
    if (!S.next(0, cur)) return;
    f32x4 acc[2][2][4][2];
#pragma unroll
    for (int a = 0; a < 2; ++a)
#pragma unroll
        for (int b = 0; b < 2; ++b)
#pragma unroll
            for (int m = 0; m < 4; ++m)
#pragma unroll
                for (int n = 0; n < 2; ++n) acc[a][b][m][n] = (f32x4){0.f, 0.f, 0.f, 0.f};
    bf16x8 At[4][2], B0[2][2], B1[2][2];
    const char* cA = (const char*)g.A + cur.aoff; const char* cB = (const char*)g.Bt + cur.boff;
    {
        PG8_STAGE(PG8_SB(0, 0), cB, voffB); PG8_STAGE(PG8_SB(0, 1), cB + hstepB, voffB); PG8_STAGE(PG8_SA(0, 0), cA, voffA); PG8_STAGE(PG8_SA(0, 1), cA + hstepA, voffA);
        if (wr == 1) PG8_BAR;
        PG8_WAIT_V(2); PG8_BAR;
        PG8_STAGE(PG8_SB(1, 0), cB + kstep, voffB); PG8_STAGE(PG8_SA(1, 0), cA + kstep, voffA); PG8_STAGE(PG8_SB(1, 1), cB + hstepB + kstep, voffB);
        PG8_WAIT_V(6); PG8_BAR;
    }
    for (;;) {
        const bool has_next = S.next(ui + 1, nxt);
        const char* nA = has_next ? (const char*)g.A + nxt.aoff : cA; const char* nB = has_next ? (const char*)g.Bt + nxt.boff : cB;
#pragma unroll 1
        for (int t = 0; t < nt; t += 2) {
            if constexpr (Epi::HOOK) { if (t == 8 || t == 16) { E.hook(acc, cur, t >> 3, wr, wc, fr, fq); PG8_WAIT_V(0); } }
            const bool last = (t == nt - 2);
            const char* a1 = cA + (size_t)(t + 1) * kstep;
            const char* a2 = last ? nA : cA + (size_t)(t + 2) * kstep; const char* b2 = last ? nB : cB + (size_t)(t + 2) * kstep;
            const char* a3 = a2 + kstep; const char* b3 = b2 + kstep;
            PG8_LDB(B0, 0, 0); PG8_LDB(B1, 0, 1); PG8_SCHED; PG8_LDA(At, 0, 0); PG8_STAGE(PG8_SA(1, 1), a1 + hstepA, voffA);
            PG8_WAIT_V(8); PG8_WAIT_L(0); PG8_BAR; PG8_MMA(0, 0, At, B0); PG8_MMA(0, 1, At, B1); PG8_BAR; PG8_SCHED;
            PG8_LDA(At, 0, 1); PG8_STAGE(PG8_SB(0, 0), b2, voffB); PG8_STAGE(PG8_SB(0, 1), b2 + hstepB, voffB); PG8_STAGE(PG8_SA(0, 0), a2, voffA);
            PG8_WAIT_V(8); PG8_WAIT_L(0); PG8_BAR; PG8_MMA(1, 0, At, B0); PG8_MMA(1, 1, At, B1); PG8_BAR; PG8_SCHED;
            PG8_LDB(B0, 1, 0); PG8_LDB(B1, 1, 1); PG8_SCHED; PG8_LDA(At, 1, 0); PG8_STAGE(PG8_SA(0, 1), a2 + hstepA, voffA);
            PG8_WAIT_V(8); PG8_WAIT_L(0); PG8_BAR; PG8_MMA(0, 0, At, B0); PG8_MMA(0, 1, At, B1); PG8_BAR; PG8_SCHED;
            PG8_LDA(At, 1, 1); PG8_STAGE(PG8_SB(1, 0), b3, voffB); PG8_STAGE(PG8_SB(1, 1), b3 + hstepB, voffB); PG8_STAGE(PG8_SA(1, 0), a3, voffA);
            PG8_WAIT_V(8); PG8_WAIT_L(0); PG8_BAR; PG8_MMA(1, 0, At, B0); PG8_MMA(1, 1, At, B1); PG8_BAR; PG8_SCHED;
        }
        if (wr == 0) PG8_BAR;
        E(acc, cur, wr, wc, fr, fq);
        if (!has_next) break;
#pragma unroll
        for (int a = 0; a < 2; ++a)
#pragma unroll
            for (int b = 0; b < 2; ++b)
#pragma unroll
                for (int m = 0; m < 4; ++m)
#pragma unroll
                    for (int n = 0; n < 2; ++n) acc[a][b][m][n] = (f32x4){0.f, 0.f, 0.f, 0.f};
        cur = nxt; cA = nA; cB = nB; ++ui;
        if (wr == 1) PG8_BAR;
    }
    PG8_WAIT_V(0);
    PG8_BAR;
#undef PG8_SA
#undef PG8_SB
#undef PG8_STAGE
#undef PG8_LDA
#undef PG8_LDB
#undef PG8_MMA
#undef PG8_WAIT_V
#undef PG8_WAIT_L
#undef PG8_BAR
#undef PG8_SCHED
}

template <class F> struct Epi8 {
    static constexpr bool PERM = true, HOOK = false;
    F f;
    __device__ __forceinline__ void operator()(const f32x4 (&acc)[2][2][4][2], const Unit& u, int wr, int wc, int fr, int fq) const {
#pragma unroll
        for (int ai = 0; ai < 2; ++ai)
#pragma unroll
            for (int m = 0; m < 4; ++m) {
                const int row = u.pm * BM + ai * HALF + wr * 64 + m * 16 + fr;
#pragma unroll
                for (int bj = 0; bj < 2; ++bj) f(u, row, bj * HALF + wc * 32 + 8 * fq, acc[ai][bj][m][0], acc[ai][bj][m][1]);
            }
    }
};
}
using pg8::Unit;

__device__ __forceinline__ u32x4 pack8(f32x4 a, f32x4 b) { u32x4 w; w.x = pk2(a[0], a[1]); w.y = pk2(a[2], a[3]); w.z = pk2(b[0], b[1]); w.w = pk2(b[2], b[3]); return w; }
__device__ __forceinline__ void unpack8(u32x4 w, f32x4& a, f32x4& b) { a = (f32x4){bf_lo(w.x), bf_hi(w.x), bf_lo(w.y), bf_hi(w.y)}; b = (f32x4){bf_lo(w.z), bf_hi(w.z), bf_lo(w.w), bf_hi(w.w)}; }

struct FProj {
    GAS bf16_t* Ap; GAS bf16_t* P; GAS bf16_t* CQR; const GAS float* b_gate;
    __device__ __forceinline__ void operator()(const Unit& u, int row, int col, f32x4 v0, f32x4 v1) const {
        const int pn = u.pn;
        if (pn < 2) {
            const int c = pn * 256 + col, g = c >> 4, p = c & 15;
            *(GAS u32x4*)(Ap + ((size_t)(g * 2048 + (row >> 4)) * 512 + (row & 15) * 16 + p)) = pack8(v0, v1);
        } else if (pn < 22) {
            const int pc = pn * 256 - 512 + col;
            if (pn >= 10) {
                const f32x4 b0 = *(const GAS f32x4*)(b_gate + pc - PC_GATE), b1 = *(const GAS f32x4*)(b_gate + pc - PC_GATE + 4);
#pragma unroll
                for (int i = 0; i < 4; ++i) { v0[i] = sigmoidf_(v0[i] + b0[i]); v1[i] = sigmoidf_(v1[i] + b1[i]); }
            } else if (pn == 8 || pn == 9) {
                const float sc = 0.08838834764831845f * LOG2E;
                v0 = v0 * sc; v1 = v1 * sc;
            } else {
#pragma unroll
                for (int i = 0; i < 4; ++i) { v0[i] = siluf_(v0[i]); v1[i] = siluf_(v1[i]); }
            }
            *(GAS u32x4*)(P + (size_t)row * PW + pc) = pack8(v0, v1);
        } else {
            *(GAS u32x4*)(CQR + (size_t)row * 512 + (pn - 22) * 256 + col) = pack8(v0, v1);
        }
    }
};
struct FStore {
    GAS bf16_t* O; int ldc;
    __device__ __forceinline__ void operator()(const Unit& u, int row, int col, f32x4 v0, f32x4 v1) const {
        *(GAS u32x4*)(O + (size_t)row * ldc + u.pn * 256 + col) = pack8(v0, v1);
    }
};
struct FVtMem {
    GAS bf16_t* O;
    __device__ __forceinline__ void operator()(const Unit& u, int row, int col, f32x4 v0, f32x4 v1) const {
        *(GAS u32x4*)(O + ((size_t)(u.pn * 512 + row) * 256 + col)) = pack8(v0, v1);
    }
};
struct FKnope {
    GAS bf16_t* O;
    __device__ __forceinline__ void operator()(const Unit& u, int row, int col, f32x4 v0, f32x4 v1) const {
        const int c = u.pn * 256 + col;
        *(GAS u32x4*)(O + (size_t)row * 768 + (c >> 6) * 96 + (c & 63)) = pack8(v0, v1);
    }
};
struct FVt {
    GAS bf16_t* O;
    __device__ __forceinline__ void operator()(const Unit& u, int row, int col, f32x4 v0, f32x4 v1) const {
        const int b = u.pn >> 4, tl = (u.pn & 15) * 256 + col;
        *(GAS u32x4*)(O + ((size_t)(b * 512 + row) * 4096 + tl)) = pack8(v0, v1);
    }
};
struct FSsmY {
    GAS bf16_t* Y;
    __device__ __forceinline__ void operator()(const Unit& u, int row, int col, f32x4 v0, f32x4 v1) const {
        const int g = row >> 11, rowg = row & 2047, j = col >> 4, p = col & 15;
#pragma unroll
        for (int i = 0; i < 4; ++i) { v0[i] = gelu_tanh(v0[i]); v1[i] = gelu_tanh(v1[i]); }
        *(GAS u32x4*)(Y + ((size_t)(rowg * 16 + j) * 512 + g * 16 + p)) = pack8(v0, v1);
    }
};
struct FGlu {
    const GAS bf16_t* Y; GAS bf16_t* P; const GAS float* glu_b;
    __device__ __forceinline__ void operator()(const Unit& u, int row, int col, f32x4 v0, f32x4 v1) const {
        const int c = u.pn * 256 + col;
        const f32x4 b0 = *(const GAS f32x4*)(glu_b + c), b1 = *(const GAS f32x4*)(glu_b + c + 4);
        f32x4 y0, y1, z0, z1; unpack8(*(const GAS u32x4*)(Y + (size_t)row * 512 + c), y0, y1);
        GAS bf16_t* zp = P + (size_t)row * PW + PC_ZSSM + c; unpack8(*(const GAS u32x4*)zp, z0, z1);
#pragma unroll
        for (int i = 0; i < 4; ++i) { v0[i] = y0[i] * sigmoidf_(v0[i] + b0[i]) * z0[i]; v1[i] = y1[i] * sigmoidf_(v1[i] + b1[i]) * z1[i]; }
        *(GAS u32x4*)zp = pack8(v0, v1);
    }
};
struct FBranch {
    const GAS bf16_t* P; GAS bf16_t* Mg;
    __device__ __forceinline__ void operator()(const Unit& u, int row, int col, f32x4 v0, f32x4 v1) const {
        const int c = u.pn * 256 + col, seg = u.aux;
        f32x4 g0, g1; unpack8(*(const GAS u32x4*)(P + (size_t)row * PW + PC_GATE + seg * 1024 + c), g0, g1);
        GAS bf16_t* mp = Mg + (size_t)row * 1024 + c;
        v0 = v0 * g0; v1 = v1 * g1;
        if (seg != 0) { f32x4 m0, m1; unpack8(*(const GAS u32x4*)mp, m0, m1); v0 = v0 + m0; v1 = v1 + m1; }
        *(GAS u32x4*)mp = pack8(v0, v1);
    }
};
struct EpiBranchH {
    static constexpr bool PERM = true, HOOK = true;
    const GAS bf16_t* Pg; GAS bf16_t* Mgp;
    __device__ __forceinline__ void hook(f32x4 (&acc)[2][2][4][2], const Unit& u, int seg, int wr, int wc, int fr, int fq) const {
        const GAS bf16_t* gbase = Pg + (size_t)(u.pm * 256 + wr * 64 + fr) * PW + PC_GATE + (seg - 1) * 1024 + u.pn * 256 + wc * 32 + 8 * fq;
#pragma unroll
        for (int ai = 0; ai < 2; ++ai) {
            u32x4 ga[4][2], gb[4][2];
#pragma unroll
            for (int m = 0; m < 4; ++m)
#pragma unroll
                for (int bj = 0; bj < 2; ++bj) { const GAS bf16_t* gp = gbase + (size_t)(ai * 128 + m * 16) * PW + bj * 128;
                    ga[m][bj] = *(const GAS u32x4*)gp; gb[m][bj] = *(const GAS u32x4*)(gp + 1024); }
#pragma unroll
            for (int m = 0; m < 4; ++m)
#pragma unroll
                for (int bj = 0; bj < 2; ++bj) { f32x4 a0, a1, b0, b1; unpack8(ga[m][bj], a0, a1); unpack8(gb[m][bj], b0, b1);
#pragma unroll
                    for (int i = 0; i < 4; ++i) { acc[ai][bj][m][0][i] *= a0[i] * frcp(b0[i]); acc[ai][bj][m][1][i] *= a1[i] * frcp(b1[i]); } }
            asm volatile("" ::: "memory");
        }
    }
    __device__ __forceinline__ void operator()(const f32x4 (&acc)[2][2][4][2], const Unit& u, int wr, int wc, int fr, int fq) const {
#pragma unroll
        for (int ai = 0; ai < 2; ++ai)
#pragma unroll
            for (int m = 0; m < 4; ++m) {
                const int row = u.pm * 256 + ai * 128 + wr * 64 + m * 16 + fr;
#pragma unroll
                for (int bj = 0; bj < 2; ++bj) {
                    const int c = u.pn * 256 + bj * 128 + wc * 32 + 8 * fq;
                    f32x4 g0, g1; unpack8(*(const GAS u32x4*)(Pg + (size_t)row * PW + PC_GATE + 2048 + c), g0, g1);
                    *(GAS u32x4*)(Mgp + (size_t)row * 1024 + c) = pack8(acc[ai][bj][m][0] * g0, acc[ai][bj][m][1] * g1);
                }
            }
    }
};
struct EpiOutRS {
    static constexpr bool PERM = true, HOOK = false;
    GAS bf16_t* O; LAS float* rsq;
    __device__ __forceinline__ void operator()(const f32x4 (&acc)[2][2][4][2], const Unit& u, int wr, int wc, int fr, int fq) const {
#pragma unroll
        for (int ai = 0; ai < 2; ++ai)
#pragma unroll
            for (int m = 0; m < 4; ++m) {
                const int rl = ai * 128 + wr * 64 + m * 16 + fr; const size_t row = (size_t)u.pm * 256 + rl;
                float sq = 0.f;
#pragma unroll
                for (int bj = 0; bj < 2; ++bj) {
                    const f32x4 v0 = acc[ai][bj][m][0], v1 = acc[ai][bj][m][1];
                    *(GAS u32x4*)(O + row * 1024 + u.pn * 256 + bj * 128 + wc * 32 + 8 * fq) = pack8(v0, v1);
                    sq += (v0[0] * v0[0] + v0[1] * v0[1]) + (v0[2] * v0[2] + v0[3] * v0[3]) + (v1[0] * v1[0] + v1[1] * v1[1]) + (v1[2] * v1[2] + v1[3] * v1[3]);
                }
                sq += __shfl_xor(sq, 16); sq += __shfl_xor(sq, 32);
                if (fq == 0) rsq[(u.aux * 4 + wc) * 256 + rl] = sq;
            }
    }
};
struct EpiQ {
    static constexpr bool PERM = false, HOOK = false;
    GAS bf16_t* Q; const GAS float* cosT; const GAS float* sinT;
    __device__ __forceinline__ void operator()(const f32x4 (&acc)[2][2][4][2], const Unit& u, int wr, int wc, int fr, int fq) const {
        const float sc = 0.10206207261596577f * LOG2E;
#pragma unroll
        for (int ai = 0; ai < 2; ++ai)
#pragma unroll
            for (int m = 0; m < 4; ++m) {
                const int row = u.pm * 256 + ai * 128 + wr * 64 + m * 16 + fr;
#pragma unroll
                for (int bj = 0; bj < 2; ++bj) {
                    const int c0 = u.pn * 256 + bj * 128 + wc * 32;
                    f32x4 a = acc[ai][bj][m][0] * sc, b = acc[ai][bj][m][1] * sc;
                    if ((c0 % 96) == 64) {
                        const f32x4 cs = *(const GAS f32x4*)(cosT + (size_t)row * 16 + 4 * fq), sn = *(const GAS f32x4*)(sinT + (size_t)row * 16 + 4 * fq);
                        const f32x4 ra = a * cs - b * sn, rb = b * cs + a * sn; a = ra; b = rb;
                    }
                    u32x2 w0, w1; w0.x = pk2(a[0], a[1]); w0.y = pk2(a[2], a[3]); w1.x = pk2(b[0], b[1]); w1.y = pk2(b[2], b[3]);
                    GAS bf16_t* qp = Q + (size_t)row * 768 + c0 + 4 * fq;
                    *(GAS u32x2*)qp = w0; *(GAS u32x2*)(qp + 16) = w1;
                }
            }
    }
};

template <int DQK, int DV, int RH, bool NEGM>
__device__ __forceinline__ void attn_unit(LAS unsigned char* lds, const GAS bf16_t* Q, int qpitch, const GAS bf16_t* K, int kpitch,
                                          const GAS bf16_t* Vt, int vpitch, int nkv, const GAS bf16_t* ZI, GAS bf16_t* ZO, int zpitch, const int wave_) {
    constexpr int CH = DQK / 8, KCH = 64 * CH, NKL = (KCH + 511) / 512, VCH = DV * 8, NVL = VCH / 512;
    constexpr int KROWB = (DQK + 8) * 2, KBUF = 64 * KROWB, VROWB = 136, VBUF = DV * VROWB;
    int lane_ = lane_id_(); asm volatile("" : "+v"(lane_));
    const int lane = lane_, wid = wave_, tid = wave_ * 64 + lane, r32 = lane & 31, hi = lane >> 5;
    const bool grpB = false;
    LAS unsigned char* Kl = lds; LAS unsigned char* Vl = lds + 2 * KBUF;
    bf16x8 qf[RH][DQK / 16];
#pragma unroll
    for (int hh = 0; hh < RH; ++hh) { const GAS bf16_t* qp = Q + (size_t)(wid * 32 * RH + hh * 32 + r32) * qpitch + hi * 8;
#pragma unroll
      for (int d0 = 0; d0 < DQK / 16; ++d0) qf[hh][d0] = *(const GAS bf16x8*)(qp + d0 * 16); }
    u32x4 kr[NKL], vr[NVL];
#define AT_GLOAD(t) do { \
        _Pragma("unroll") for (int i_ = 0; i_ < NKL; ++i_) { const int id_ = tid + i_ * 512; if (id_ < KCH) { const int r_ = id_ / CH, c_ = id_ % CH; kr[i_] = *(const GAS u32x4*)(K + (size_t)((t) * 64 + r_) * kpitch + c_ * 8); } } \
        _Pragma("unroll") for (int i_ = 0; i_ < NVL; ++i_) { const int id_ = tid + i_ * 512; const int r_ = id_ >> 3, c_ = id_ & 7; vr[i_] = *(const GAS u32x4*)(Vt + (size_t)r_ * vpitch + (t) * 64 + c_ * 8); } } while (0)
#define AT_LSTORE(kb_, vs_) do { \
        _Pragma("unroll") for (int i_ = 0; i_ < NKL; ++i_) { const int id_ = tid + i_ * 512; if (id_ < KCH) { const int r_ = id_ / CH, c_ = id_ % CH; *(LAS u32x4*)(Kl + (kb_) * KBUF + r_ * KROWB + c_ * 16) = kr[i_]; } } \
        _Pragma("unroll") for (int i_ = 0; i_ < NVL; ++i_) { const int id_ = tid + i_ * 512; const int r_ = id_ >> 3, c_ = id_ & 7; LAS unsigned char* p_ = Vl + (vs_) * VBUF + r_ * VROWB + c_ * 16; \
            *(LAS u32x2*)p_ = (u32x2){vr[i_].x, vr[i_].y}; *(LAS u32x2*)(p_ + 8) = (u32x2){vr[i_].z, vr[i_].w}; } } while (0)
    f32x16 o[RH][DV / 32];
#pragma unroll
    for (int hh = 0; hh < RH; ++hh)
#pragma unroll
        for (int dt = 0; dt < DV / 32; ++dt)
#pragma unroll
            for (int r = 0; r < 16; ++r) o[hh][dt][r] = 0.f;
    float mref[RH], lacc[RH][4];
#pragma unroll
    for (int hh = 0; hh < RH; ++hh) { mref[hh] = 0.f; lacc[hh][0] = lacc[hh][1] = lacc[hh][2] = lacc[hh][3] = 0.f; }
    f32x16 zero16;
#pragma unroll
    for (int r = 0; r < 16; ++r) zero16[r] = 0.f;
    f32x16 negm[RH];
    float zf_ = 0.f; asm volatile("" : "+v"(zf_));
#pragma unroll
    for (int hh = 0; hh < RH; ++hh) {
#pragma unroll
        for (int r = 0; r < 16; ++r) negm[hh][r] = zf_;
        if constexpr (NEGM) asm volatile("" : "+v"(negm[hh])); }
    bf16x8 pb[RH][4];
    bf16x8 vf[NEGM ? DV / 32 : 1][4];
    bf16x8 ka_[NEGM ? DQK / 16 : 1], kb2_[NEGM ? DQK / 16 : 1];
    bool first = true;
#define AT_KLD2(d0_) do { _Pragma("unroll") for (int dd_ = (d0_); dd_ < (d0_) + 2; ++dd_) { ka_[dd_] = *(const LAS bf16x8*)(kbp_ + dd_ * 32); kb2_[dd_] = *(const LAS bf16x8*)(kbp_ + 32 * KROWB + dd_ * 32); } } while (0)
#define AT_KMM2(d0_) do { _Pragma("unroll") for (int dd_ = (d0_); dd_ < (d0_) + 2; ++dd_) _Pragma("unroll") for (int hh = 0; hh < RH; ++hh) { \
                p[hh][0] = __builtin_amdgcn_mfma_f32_32x32x16_bf16(ka_[dd_], qf[hh][dd_], dd_ == 0 ? negm[hh] : p[hh][0], 0, 0, 0); \
                p[hh][1] = __builtin_amdgcn_mfma_f32_32x32x16_bf16(kb2_[dd_], qf[hh][dd_], dd_ == 0 ? negm[hh] : p[hh][1], 0, 0, 0); } } while (0)
#define AT_QK_LD0(kb_) do { if constexpr (NEGM) { const LAS unsigned char* kbp_ = Kl + (kb_) * KBUF + r32 * KROWB + hi * 16; AT_KLD2(0); __builtin_amdgcn_sched_barrier(0); } } while (0)
#define AT_QK(kb_) do { \
        const LAS unsigned char* kbp_ = Kl + (kb_) * KBUF + r32 * KROWB + hi * 16; \
        if constexpr (NEGM) {            \
            AT_KLD2(2); AT_KMM2(0); __builtin_amdgcn_sched_barrier(0); \
            AT_KLD2(4); AT_KMM2(2); __builtin_amdgcn_sched_barrier(0); \
            AT_KMM2(4); \
        } else { \
        _Pragma("unroll") for (int d0 = 0; d0 < DQK / 16; ++d0) { \
            const bf16x8 a0 = *(const LAS bf16x8*)(kbp_ + d0 * 32), a1 = *(const LAS bf16x8*)(kbp_ + 32 * KROWB + d0 * 32); \
            _Pragma("unroll") for (int hh = 0; hh < RH; ++hh) { \
                p[hh][0] = __builtin_amdgcn_mfma_f32_32x32x16_bf16(a0, qf[hh][d0], d0 == 0 ? zero16 : p[hh][0], 0, 0, 0); \
                p[hh][1] = __builtin_amdgcn_mfma_f32_32x32x16_bf16(a1, qf[hh][d0], d0 == 0 ? zero16 : p[hh][1], 0, 0, 0); } } } } while (0)
#define AT_SOFTMAX() do { \
        _Pragma("unroll") for (int hh = 0; hh < RH; ++hh) { \
            if constexpr (!NEGM) { const float mr_ = mref[hh]; _Pragma("unroll") for (int r = 0; r < 16; ++r) { p[hh][0][r] -= mr_; p[hh][1][r] -= mr_; } } \
            float mxa = __builtin_fmaxf(p[hh][0][0], p[hh][1][0]), mxb = __builtin_fmaxf(p[hh][0][1], p[hh][1][1]), mxc = __builtin_fmaxf(p[hh][0][2], p[hh][1][2]), mxd = __builtin_fmaxf(p[hh][0][3], p[hh][1][3]); \
            _Pragma("unroll") for (int r = 4; r < 16; r += 4) { mxa = __builtin_fmaxf(__builtin_fmaxf(mxa, p[hh][0][r]), p[hh][1][r]); mxb = __builtin_fmaxf(__builtin_fmaxf(mxb, p[hh][0][r + 1]), p[hh][1][r + 1]); \
                mxc = __builtin_fmaxf(__builtin_fmaxf(mxc, p[hh][0][r + 2]), p[hh][1][r + 2]); mxd = __builtin_fmaxf(__builtin_fmaxf(mxd, p[hh][0][r + 3]), p[hh][1][r + 3]); } \
            float mx = __builtin_fmaxf(__builtin_fmaxf(mxa, mxb), __builtin_fmaxf(mxc, mxd)); \
            { auto rr_ = __builtin_amdgcn_permlane32_swap(__float_as_uint(mx), __float_as_uint(mx), false, false); mx = __builtin_fmaxf(__uint_as_float(rr_[0]), __uint_as_float(rr_[1])); } \
            if (first || __any(mx > 8.f)) {              \
                const float dl = first ? mx : __builtin_fmaxf(mx, 0.f), alpha = fexp2(-dl); \
                mref[hh] += dl; lacc[hh][0] *= alpha; lacc[hh][1] *= alpha; lacc[hh][2] *= alpha; lacc[hh][3] *= alpha; \
                if constexpr (NEGM) { _Pragma("unroll") for (int r = 0; r < 16; ++r) negm[hh][r] = -mref[hh]; asm volatile("" : "+v"(negm[hh])); } \
                _Pragma("unroll") for (int r = 0; r < 16; ++r) { p[hh][0][r] -= dl; p[hh][1][r] -= dl; } \
                _Pragma("unroll") for (int dt = 0; dt < DV / 32; ++dt) _Pragma("unroll") for (int r = 0; r < 16; ++r) o[hh][dt][r] *= alpha; \
            } \
            _Pragma("unroll") for (int r = 0; r < 16; ++r) { p[hh][0][r] = fexp2(p[hh][0][r]); p[hh][1][r] = fexp2(p[hh][1][r]); } \
            _Pragma("unroll") for (int r = 0; r < 16; r += 4) { lacc[hh][0] += p[hh][0][r] + p[hh][1][r]; lacc[hh][1] += p[hh][0][r + 1] + p[hh][1][r + 1]; lacc[hh][2] += p[hh][0][r + 2] + p[hh][1][r + 2]; lacc[hh][3] += p[hh][0][r + 3] + p[hh][1][r + 3]; } \
            u32x4 w; \
            w.x = pk2(p[hh][0][0], p[hh][0][1]); w.y = pk2(p[hh][0][2], p[hh][0][3]); w.z = pk2(p[hh][0][4], p[hh][0][5]); w.w = pk2(p[hh][0][6], p[hh][0][7]); pb[hh][0] = __builtin_bit_cast(bf16x8, w); \
            w.x = pk2(p[hh][0][8], p[hh][0][9]); w.y = pk2(p[hh][0][10], p[hh][0][11]); w.z = pk2(p[hh][0][12], p[hh][0][13]); w.w = pk2(p[hh][0][14], p[hh][0][15]); pb[hh][1] = __builtin_bit_cast(bf16x8, w); \
            w.x = pk2(p[hh][1][0], p[hh][1][1]); w.y = pk2(p[hh][1][2], p[hh][1][3]); w.z = pk2(p[hh][1][4], p[hh][1][5]); w.w = pk2(p[hh][1][6], p[hh][1][7]); pb[hh][2] = __builtin_bit_cast(bf16x8, w); \
            w.x = pk2(p[hh][1][8], p[hh][1][9]); w.y = pk2(p[hh][1][10], p[hh][1][11]); w.z = pk2(p[hh][1][12], p[hh][1][13]); w.w = pk2(p[hh][1][14], p[hh][1][15]); pb[hh][3] = __builtin_bit_cast(bf16x8, w); \
        } first = false; } while (0)
#define AT_VLOAD(vs_) do { if constexpr (NEGM) { \
        _Pragma("unroll") for (int dt = 0; dt < DV / 32; ++dt) { \
            const LAS unsigned char* vb_ = Vl + (vs_) * VBUF + (dt * 32 + r32) * VROWB + hi * 8; \
            _Pragma("unroll") for (int ks = 0; ks < 4; ++ks) { \
                const u32x2 lo_ = *(const LAS u32x2*)(vb_ + ks * 32), hh2_ = *(const LAS u32x2*)(vb_ + ks * 32 + 16); \
                const u32x4 aw_ = {lo_.x, lo_.y, hh2_.x, hh2_.y}; vf[dt][ks] = __builtin_bit_cast(bf16x8, aw_); } } \
        __builtin_amdgcn_sched_barrier(0); } } while (0)
#define AT_PV(vs_) do { if constexpr (NEGM) { \
        _Pragma("unroll") for (int ks = 0; ks < 4; ++ks) _Pragma("unroll") for (int dt = 0; dt < DV / 32; ++dt) \
            _Pragma("unroll") for (int hh = 0; hh < RH; ++hh) o[hh][dt] = __builtin_amdgcn_mfma_f32_32x32x16_bf16(vf[dt][ks], pb[hh][ks], o[hh][dt], 0, 0, 0); \
        } else { \
        _Pragma("unroll") for (int dt = 0; dt < DV / 32; ++dt) { \
            const LAS unsigned char* vb_ = Vl + (vs_) * VBUF + (dt * 32 + r32) * VROWB + hi * 8; \
            _Pragma("unroll") for (int ks = 0; ks < 4; ++ks) { \
                const u32x2 lo_ = *(const LAS u32x2*)(vb_ + ks * 32), hh2_ = *(const LAS u32x2*)(vb_ + ks * 32 + 16); \
                const u32x4 aw_ = {lo_.x, lo_.y, hh2_.x, hh2_.y}; \
                _Pragma("unroll") for (int hh = 0; hh < RH; ++hh) o[hh][dt] = __builtin_amdgcn_mfma_f32_32x32x16_bf16(__builtin_bit_cast(bf16x8, aw_), pb[hh][ks], o[hh][dt], 0, 0, 0); } } } } while (0)
    const int NT = nkv / 64;
    AT_GLOAD(0); AT_LSTORE(0, 0); __syncthreads();
    int vs_prev = 2, vs_cur = 0, vs_next = 1;
    if (!grpB) {
        for (int t = 0; t < NT; ++t) {
            const int kb = t & 1;
            if (t + 1 < NT) AT_GLOAD(t + 1);
            f32x16 p[RH][2];
            AT_QK_LD0(kb); AT_QK(kb); AT_VLOAD(vs_cur); AT_SOFTMAX(); AT_PV(vs_cur);
            if (t + 1 < NT) AT_LSTORE(kb ^ 1, vs_next);
            __syncthreads();
            vs_prev = vs_cur; vs_cur = vs_next; vs_next = (vs_next == 2) ? 0 : vs_next + 1;
        }
    } else {
        f32x16 p[RH][2];
        { if (1 < NT) AT_GLOAD(1); AT_QK_LD0(0); AT_QK(0); if (1 < NT) AT_LSTORE(1, 1); __syncthreads(); vs_prev = 0; vs_cur = 1; vs_next = 2; }
        for (int t = 1; t < NT; ++t) {
            const int kb = t & 1;
            if (t + 1 < NT) AT_GLOAD(t + 1);
            AT_VLOAD(vs_prev); AT_SOFTMAX(); AT_QK_LD0(kb); AT_PV(vs_prev); AT_QK(kb);
            if (t + 1 < NT) AT_LSTORE(kb ^ 1, vs_next);
            __syncthreads();
            vs_prev = vs_cur; vs_cur = vs_next; vs_next = (vs_next == 2) ? 0 : vs_next + 1;
        }
        AT_VLOAD(vs_prev); AT_SOFTMAX(); AT_PV(vs_prev);
    }
#undef AT_GLOAD
#undef AT_LSTORE
#undef AT_QK
#undef AT_QK_LD0
#undef AT_KLD2
#undef AT_KMM2
#undef AT_SOFTMAX
#undef AT_PV
#undef AT_VLOAD
#pragma unroll
    for (int hh = 0; hh < RH; ++hh) {
        float l = (lacc[hh][0] + lacc[hh][1]) + (lacc[hh][2] + lacc[hh][3]); l += __shfl_xor(l, 32);
        const float inv = 1.f / l;
        const size_t ro = (size_t)(wid * 32 * RH + hh * 32 + r32) * zpitch;
#pragma unroll
        for (int dt = 0; dt < DV / 32; ++dt)
#pragma unroll
            for (int i = 0; i < 4; ++i) {
                const int c = dt * 32 + 8 * i + 4 * hi;
                const u32x2 zw = *(const GAS u32x2*)(ZI + ro + c);
                u32x2 w;
                w.x = pk2(o[hh][dt][4 * i + 0] * inv * bf_lo(zw.x), o[hh][dt][4 * i + 1] * inv * bf_hi(zw.x));
                w.y = pk2(o[hh][dt][4 * i + 2] * inv * bf_lo(zw.y), o[hh][dt][4 * i + 3] * inv * bf_hi(zw.y));
                *(GAS u32x2*)(ZO + ro + c) = w;
            }
    }
    __syncthreads();
}

__device__ __forceinline__ void transpose_item(const GAS float* W, int N, int k0, int n0, GAS bf16_t* WT, int ldt, int drow0, LAS float* scr, int lane) {
    float tv[32];
#pragma unroll
    for (int i = 0; i < 32; ++i) { const int kk = 2 * i + (lane >> 5); tv[i] = __builtin_nontemporal_load(W + (size_t)(k0 + kk) * N + n0 + (lane & 31)); }
#pragma unroll
    for (int i = 0; i < 32; ++i) { const int kk = 2 * i + (lane >> 5); scr[kk * 33 + (lane & 31)] = tv[i]; }
    asm volatile("s_waitcnt lgkmcnt(0)" ::: "memory");
    const int c = lane & 7;
#pragma unroll
    for (int j = 0; j < 4; ++j) { const int n = (lane >> 3) + 8 * j; const LAS float* s = scr + (8 * c) * 33 + n;
        u32x4 o; o.x = pk2(s[0 * 33], s[1 * 33]); o.y = pk2(s[2 * 33], s[3 * 33]); o.z = pk2(s[4 * 33], s[5 * 33]); o.w = pk2(s[6 * 33], s[7 * 33]);
        *(GAS u32x4*)(WT + (size_t)(drow0 + n) * ldt + k0 + 8 * c) = o; }
    asm volatile("s_waitcnt lgkmcnt(0)" ::: "memory");
}
__device__ __forceinline__ int win_row(int n0) {
    if (n0 < 1024) return n0;
    if (n0 < 1440) return n0 - 1024 + 5632;
    if (n0 < 1952) return n0 - 1440 + 1024;
    if (n0 < 2464) return n0 - 1952 + 2048;
    if (n0 < 2976) return n0 - 2464 + 1536;
    return n0 - 2976 + 2560;
}
__device__ __forceinline__ void rms_row_1024(const GAS float* xrow, const GAS float* g, GAS bf16_t* orow, int lane) {
    const GAS f32x4* xr = (const GAS f32x4*)xrow + lane; const GAS f32x4* gr = (const GAS f32x4*)g + lane;
    f32x4 v[4]; float s = 0.f;
#pragma unroll
    for (int j = 0; j < 4; ++j) { v[j] = xr[64 * j]; s += (v[j].x * v[j].x + v[j].y * v[j].y) + (v[j].z * v[j].z + v[j].w * v[j].w); }
    const float rstd = 1.f / sqrtf(wave_sum(s) * (1.f / 1024.f) + NORM_EPS);
    GAS u32x2* o8 = (GAS u32x2*)orow + lane;
#pragma unroll
    for (int j = 0; j < 4; ++j) { const f32x4 gg = gr[64 * j]; u32x2 w; w.x = pk2(v[j].x * rstd * gg.x, v[j].y * rstd * gg.y); w.y = pk2(v[j].z * rstd * gg.z, v[j].w * rstd * gg.w); o8[64 * j] = w; }
}

__device__ __forceinline__ void rms_row2_1024(const GAS float* x0, const GAS float* x1, const GAS float* g, GAS bf16_t* o0, GAS bf16_t* o1, int lane) {
    const GAS f32x4* xr0 = (const GAS f32x4*)x0 + lane; const GAS f32x4* xr1 = (const GAS f32x4*)x1 + lane; const GAS f32x4* gr = (const GAS f32x4*)g + lane;
    f32x4 v[4], w[4]; float s = 0.f, s2 = 0.f;
#pragma unroll
    for (int j = 0; j < 4; ++j) { v[j] = __builtin_nontemporal_load(xr0 + 64 * j); w[j] = __builtin_nontemporal_load(xr1 + 64 * j); }
#pragma unroll
    for (int j = 0; j < 4; ++j) { s += (v[j].x * v[j].x + v[j].y * v[j].y) + (v[j].z * v[j].z + v[j].w * v[j].w); s2 += (w[j].x * w[j].x + w[j].y * w[j].y) + (w[j].z * w[j].z + w[j].w * w[j].w); }
#pragma unroll
    for (int o = 1; o < 64; o <<= 1) { s += __shfl_xor(s, o); s2 += __shfl_xor(s2, o); }
    const float r0 = 1.f / sqrtf(s * (1.f / 1024.f) + NORM_EPS), r1 = 1.f / sqrtf(s2 * (1.f / 1024.f) + NORM_EPS);
    GAS u32x2* p0 = (GAS u32x2*)o0 + lane; GAS u32x2* p1 = (GAS u32x2*)o1 + lane;
#pragma unroll
    for (int j = 0; j < 4; ++j) { const f32x4 gg = gr[64 * j]; u32x2 a, b;
        a.x = pk2(v[j].x * r0 * gg.x, v[j].y * r0 * gg.y); a.y = pk2(v[j].z * r0 * gg.z, v[j].w * r0 * gg.w);
        b.x = pk2(w[j].x * r1 * gg.x, w[j].y * r1 * gg.y); b.y = pk2(w[j].z * r1 * gg.z, w[j].w * r1 * gg.w);
        p0[64 * j] = a; p1[64 * j] = b; }
}


#define XB_TMO      128
#define XB_XCNT(j)  (256  + 64 * (j))
#define XB_XSUB(j)  (1280 + 64 * (j))
#define XB_XGEN(j)  (2304 + 64 * (j))
#define XB_TOP      3328
#define XB_TOPGEN   3392
#define XCD_BAR_WORDS 3456
#define XB_SPIN_CAP (1u << 18)
__device__ __forceinline__ unsigned xb_ld(unsigned* p)              { return __hip_atomic_load(p, __ATOMIC_RELAXED, __HIP_MEMORY_SCOPE_AGENT); }
__device__ __forceinline__ unsigned xb_add(unsigned* p, unsigned v) { return __hip_atomic_fetch_add(p, v, __ATOMIC_RELAXED, __HIP_MEMORY_SCOPE_AGENT); }
__device__ __forceinline__ unsigned xb_xcc_id() { return (unsigned)__builtin_amdgcn_s_getreg((3 << 11) | 20) & 0xFu; }
#define XB_SPIN(cond, bar) do { unsigned _sp = 0; while (cond) { __builtin_amdgcn_s_sleep(1); \
    if ((++_sp & 255u) == 0u) { if (xb_ld(&(bar)[XB_TMO])) break; if (_sp > XB_SPIN_CAP) { atomicAdd(&(bar)[XB_TMO], 1u); break; } } } } while (0)
struct XcdBarrier { unsigned* bar; unsigned x; volatile LAS unsigned* st; };
__device__ __forceinline__ XcdBarrier xcd_barrier_post(unsigned* bar, volatile LAS unsigned* st) {
    XcdBarrier b; b.bar = bar; b.x = xb_xcc_id(); b.st = st;
    if (threadIdx.x == 0) (void)xb_add(&bar[XB_XCNT(b.x)], 1u);
    return b;
}
__device__ __forceinline__ void xcd_barrier_complete(unsigned* bar, unsigned x, unsigned& nloc, unsigned& nx) {
    const unsigned G = gridDim.x * gridDim.y * gridDim.z;
    unsigned sum, cnt, mine, sp = 0u;
    for (;;) {
        sum = 0u; cnt = 0u; mine = 0u;
#pragma unroll
        for (unsigned j = 0; j < 16; ++j) { const unsigned c = xb_ld(&bar[XB_XCNT(j)]); sum += c; cnt += (c > 0u) ? 1u : 0u; mine = (j == x) ? c : mine; }
        if (sum == G) break;
        __builtin_amdgcn_s_sleep(1);
        if ((++sp & 255u) == 0u) { if (xb_ld(&bar[XB_TMO])) break; if (sp > XB_SPIN_CAP) { atomicAdd(&bar[XB_TMO], 1u); break; } }
    }
    nloc = mine > 0u ? mine : 1u; nx = cnt > 0u ? cnt : 1u;
}
__device__ __forceinline__ void xcd_barrier(const XcdBarrier& b, const int wave_) {
    asm volatile("s_waitcnt vmcnt(0)" ::: "memory");
    __syncthreads();
    if (wave_ == 0 && lane_id_() == 0) {
        unsigned* bar = b.bar;
        __builtin_amdgcn_s_waitcnt(0);
        unsigned nloc = b.st[0], nx = b.st[1];
        if (nloc == 0u) { xcd_barrier_complete(bar, b.x, nloc, nx); b.st[0] = nloc; b.st[1] = nx; }
        const unsigned old = xb_add(&bar[XB_XSUB(b.x)], 1u);
        const unsigned gen = old / nloc;
        if (old + 1u == (gen + 1u) * nloc) {
            __builtin_amdgcn_fence(__ATOMIC_RELEASE, "agent");
            asm volatile("s_waitcnt vmcnt(0)" ::: "memory");
            const unsigned og = xb_add(&bar[XB_TOP], 1u);
            const unsigned tg = og / nx;
            if (og + 1u == (tg + 1u) * nx) xb_add(&bar[XB_TOPGEN], 1u);
            else XB_SPIN(xb_ld(&bar[XB_TOPGEN]) == tg, bar);
            __builtin_amdgcn_fence(__ATOMIC_ACQUIRE, "agent");
            xb_add(&bar[XB_XGEN(b.x)], 1u);
            asm volatile("s_waitcnt vmcnt(0)" ::: "memory");
        } else {
            XB_SPIN(xb_ld(&bar[XB_XGEN(b.x)]) == gen, bar);
            __builtin_amdgcn_fence(__ATOMIC_ACQUIRE, "agent");
            asm volatile("s_waitcnt vmcnt(0)" ::: "memory");
        }
    }
    __syncthreads();
}

struct Args {
    const float* in[27]; float* out; unsigned char* ws; int pad0, pad1;
};
enum { I_X = 0, I_MEM, I_POS, I_PRENORM, I_WIN, I_BGATE, I_LRE, I_LIM, I_LOGDT, I_BRE, I_BIM, I_CRE, I_CIM, I_SSMD, I_GLUW, I_GLUB,
       I_QNORM, I_WQUP, I_KVNORM, I_WKVUP, I_MEMNORM, I_MEMWKV, I_WBSSM, I_WBMLA, I_WBMEM, I_WOUT, I_POSTNORM };

#ifndef PHASE_MASK
#define PHASE_MASK 0xFFFFF
#endif
#define PH(n) if constexpr ((PHASE_MASK >> (n)) & 1)
constexpr int LDS_BYTES = 147456;


__device__ __forceinline__ GAS unsigned char* launder(unsigned char* p) { asm volatile("" : "+s"(p)); return (GAS unsigned char*)p; }
__device__ __forceinline__ int opq(int v) { asm volatile("" : "+s"(v)); return v; }
#define PHASE_BASES GAS unsigned char* WSB = launder(a.ws); GAS unsigned char* DOB = launder((unsigned char*)a.out); int lane_ = lane_id_(); asm volatile("" : "+v"(lane_)); const int lane = lane_, tid = wave * 64 + lane, gtid = bx * 512 + tid; (void)lane; (void)gtid; (void)DOB; (void)WSB
#define Win_t ((GAS bf16_t*)(WSB + WS_WIN))
#define Wglu_t ((GAS bf16_t*)(WSB + WS_WGLU))
#define Wq_t ((GAS bf16_t*)(WSB + WS_WQ))
#define Wk_t ((GAS bf16_t*)(WSB + WS_WK))
#define Wv_t ((GAS bf16_t*)(WSB + WS_WV))
#define Wmk_t ((GAS bf16_t*)(WSB + WS_WMK))
#define Wmv_t ((GAS bf16_t*)(WSB + WS_WMV))
#define Wbr_t ((GAS bf16_t*)(WSB + WS_WBR))
#define Wout_t ((GAS bf16_t*)(WSB + WS_WOUT))
#define ME_t ((GAS bf16_t*)(WSB + WS_MET))
#define MY_t ((GAS bf16_t*)(WSB + WS_MYT))
#define cosT ((GAS float*)(WSB + WS_COS))
#define sinT ((GAS float*)(WSB + WS_SIN))
#define apow ((GAS float*)(WSB + WS_APOW))
#define Bbar ((GAS float*)(WSB + WS_BBAR))
#define Kt ((GAS float*)(WSB + WS_KT))
#define Kmem ((GAS bf16_t*)(WSB + WS_KMEM))
#define Vtmem ((GAS bf16_t*)(WSB + WS_VTMEM))
#define P ((GAS bf16_t*)(WSB + WS_P))
#define CQR ((GAS bf16_t*)(WSB + WS_CQR))
#define Vt ((GAS bf16_t*)(WSB + WS_VT))
#define Ap ((GAS bf16_t*)(WSB + WS_AP))
#define OUTB ((GAS bf16_t*)(WSB + WS_OUT))
#define CQN ((GAS bf16_t*)(WSB + WS_CQN))
#define CKVN ((GAS bf16_t*)(WSB + WS_CKVN))
#define H ((GAS bf16_t*)(DOB + DO_H))
#define MEMN ((GAS bf16_t*)(WSB + WS_Y))
#define Eb ((GAS bf16_t*)(DOB + DO_E))
#define Kbuf ((GAS bf16_t*)(DOB + DO_KBUF))
#define Qb ((GAS bf16_t*)(DOB + DO_QB))
#define Yb ((GAS bf16_t*)(WSB + WS_Y))
#define Mg ((GAS bf16_t*)(WSB + WS_MG))

__global__ void __launch_bounds__(512, 2) fwd_mega(Args a) {
    extern __shared__ __attribute__((aligned(16))) unsigned char lds_raw[];
    LAS unsigned char* lds = (LAS unsigned char*)lds_raw;
    cg::grid_group grid = cg::this_grid();
    volatile LAS unsigned* bar_st = (volatile LAS unsigned*)(lds + 131072 + 64);
    if (threadIdx.x < 2) bar_st[threadIdx.x] = 0u;
    __syncthreads();
    const XcdBarrier xbar = xcd_barrier_post((unsigned*)(a.ws + WS_CTL), bar_st);
    if (a.pad0 != 0) grid.sync();
    const int wave = __builtin_amdgcn_readfirstlane(threadIdx.x >> 6);
    const int G = gridDim.x, bx = blockIdx.x;
    const int vcu = (G % 8 == 0) ? (bx % 8) * (G / 8) + bx / 8 : bx;
    const int gw = vcu * 8 + wave, NGW = G * 8;
    const int NTH = G * 512;
    PH(0) {
        PHASE_BASES;
        LAS float* scr = (LAS float*)(lds + wave * 16384);
        constexpr int I0 = 16 * 189, I1 = 8 * 16, I2 = 4 * 24, I3 = 2 * 32, I4 = 16 * 32, I5 = 3 * 8 * 32, I6 = 16 * 32;
        constexpr int NIT = I0 + I1 + I2 + I3 + I4 + I5 + I6;
        for (int it = gw; it < NIT; it += NGW) {
            int r = it;
            if (r < I0) { const int kb = r / 189, nb = r % 189; transpose_item(((const GAS float*)a.in[opq(I_WIN)]), 6048, kb * 64, nb * 32, Win_t, 1024, win_row(nb * 32), scr, lane); continue; } r -= I0;
            if (r < I1) { const int kb = r / 16, nb = r % 16; transpose_item(((const GAS float*)a.in[opq(I_GLUW)]), 512, kb * 64, nb * 32, Wglu_t, 512, nb * 32, scr, lane); continue; } r -= I1;
            if (r < I2) { const int kb = r / 24, nb = r % 24; transpose_item(((const GAS float*)a.in[opq(I_WQUP)]), 768, kb * 64, nb * 32, Wq_t, 256, nb * 32, scr, lane); continue; } r -= I2;
            if (r < I3) { const int kb = r / 32, nb = r % 32, n0 = nb * 32, h = n0 >> 7, w = n0 & 127;
                if (w < 64) transpose_item(((const GAS float*)a.in[opq(I_WKVUP)]), 1024, kb * 64, n0, Wk_t, 128, h * 64 + w, scr, lane);
                else transpose_item(((const GAS float*)a.in[opq(I_WKVUP)]), 1024, kb * 64, n0, Wv_t, 128, h * 64 + w - 64, scr, lane);
                continue; } r -= I3;
            if (r < I4) { const int kb = r / 32, nb = r % 32, n0 = nb * 32;
                if (n0 < 512) transpose_item(((const GAS float*)a.in[opq(I_MEMWKV)]), 1024, kb * 64, n0, Wmk_t, 1024, n0, scr, lane);
                else transpose_item(((const GAS float*)a.in[opq(I_MEMWKV)]), 1024, kb * 64, n0, Wmv_t, 1024, n0 - 512, scr, lane);
                continue; } r -= I4;
            if (r < I5) { const int seg = r / 256, rr = r % 256, kb = rr / 32, nb = rr % 32;
                const GAS float* W = seg == 0 ? ((const GAS float*)a.in[opq(I_WBSSM)]) : (seg == 1 ? ((const GAS float*)a.in[opq(I_WBMLA)]) : ((const GAS float*)a.in[opq(I_WBMEM)]));
                transpose_item(W, 1024, kb * 64, nb * 32, Wbr_t + (size_t)seg * 512, 1536, nb * 32, scr, lane); continue; } r -= I5;
            { const int kb = r / 32, nb = r % 32; transpose_item(((const GAS float*)a.in[opq(I_WOUT)]), 1024, kb * 64, nb * 32, Wout_t, 1024, nb * 32, scr, lane); }
        }
        for (int i = gtid; i < 96 * 1024 / 8; i += NTH) *(GAS u32x4*)(Win_t + (size_t)6048 * 1024 + (size_t)i * 8) = (u32x4){0u, 0u, 0u, 0u};
        { const GAS float* xin = ((const GAS float*)a.in[opq(I_X)]); const GAS float* gin = ((const GAS float*)a.in[opq(I_PRENORM)]);
          for (int m = gw; m < TOK; m += 2 * NGW) rms_row2_1024(xin + (size_t)m * 1024, xin + (size_t)(m + NGW) * 1024, gin, H + (size_t)m * 1024, H + (size_t)(m + NGW) * 1024, lane); }
        for (int m = gw; m < 2048; m += NGW) rms_row_1024(((const GAS float*)a.in[opq(I_MEM)]) + (size_t)m * 1024, ((const GAS float*)a.in[opq(I_MEMNORM)]), MEMN + (size_t)m * 1024, lane);
        { const GAS int* pos = (const GAS int*)a.in[opq(I_POS)];
          for (int i = gtid; i < TOK * 16; i += NTH) { const int t = i >> 4, j = i & 15;
              const float invf = powf(10000.f, -(float)(2 * j) / 32.f);
              float s, c; sincos_red((double)pos[t] * (double)invf, s, c); cosT[i] = c; sinT[i] = s; } }
        for (int dg = NGW - 1 - gw; dg < 64; dg += NGW) {
            const float dt = expf(((const GAS float*)a.in[opq(I_LOGDT)])[dg]);
            const float lr = ((const GAS float*)a.in[opq(I_LRE)])[dg * 64 + lane], li = ((const GAS float*)a.in[opq(I_LIM)])[dg * 64 + lane];
            float a_re = 0.f, a_im = 0.f;
            for (int e = 0; e <= 16; ++e) {
                const float mag = expf(lr * dt * (float)e); float s, c; sincos_red((double)li * (double)dt * (double)e, s, c);
                apow[((size_t)(dg * 17 + e) * 64 + lane) * 2 + 0] = mag * c; apow[((size_t)(dg * 17 + e) * 64 + lane) * 2 + 1] = mag * s;
                if (e == 1) { a_re = mag * c; a_im = mag * s; }
            }
            const float den = lr * lr + li * li, f_re = a_re - 1.f;
            const float z_re = (f_re * lr + a_im * li) / den, z_im = (a_im * lr - f_re * li) / den;
            const GAS float* bre_ = ((const GAS float*)a.in[opq(I_BRE)]); const GAS float* bim_ = ((const GAS float*)a.in[opq(I_BIM)]);
#pragma unroll
            for (int p = 0; p < 16; ++p) {
                const float br = bre_[((size_t)dg * 64 + lane) * 16 + p], bi = bim_[((size_t)dg * 64 + lane) * 16 + p];
                Bbar[(((size_t)dg * 64 + lane) * 16 + p) * 2 + 0] = z_re * br - z_im * bi;
                Bbar[(((size_t)dg * 64 + lane) * 16 + p) * 2 + 1] = z_re * bi + z_im * br;
            }
        }
    }
    xcd_barrier(xbar, wave);

    {
      PHASE_BASES;
      PH(1) {
        const GAS float* c_re = ((const GAS float*)a.in[opq(I_CRE)]); const GAS float* c_im = ((const GAS float*)a.in[opq(I_CIM)]);
        for (int idx = gtid; idx < 64 * 16 * 256; idx += NTH) {
            const int pp = idx & 255, tau = (idx >> 8) & 15, dg = idx >> 12, p = pp >> 4, p2 = pp & 15;
            float acc = 0.f;
#pragma unroll 8
            for (int n = 0; n < 64; ++n) {
                const float wr_ = apow[((size_t)(dg * 17 + tau) * 64 + n) * 2], wi_ = apow[((size_t)(dg * 17 + tau) * 64 + n) * 2 + 1];
                const float br = Bbar[(((size_t)dg * 64 + n) * 16 + p2) * 2], bi = Bbar[(((size_t)dg * 64 + n) * 16 + p2) * 2 + 1];
                const float xr = wr_ * br - wi_ * bi, xi = wr_ * bi + wi_ * br;
                acc += c_re[((size_t)dg * 16 + p) * 64 + n] * xr - c_im[((size_t)dg * 16 + p) * 64 + n] * xi;
            }
            Kt[idx] = acc;
        }
        for (int idx = gtid; idx < 32 * 256 * 32; idx += NTH) {
            const int k8 = idx & 31, o = (idx >> 5) & 255, g = idx >> 13, j = k8 >> 1, p0 = (k8 & 1) * 8;
            const int dir = o >> 7, ri = (o >> 6) & 1, n = o & 63, dg = dir * 32 + g, e = dir ? j : 15 - j;
            const float wr_ = apow[((size_t)(dg * 17 + e) * 64 + n) * 2], wi_ = apow[((size_t)(dg * 17 + e) * 64 + n) * 2 + 1];
            float v[8];
#pragma unroll
            for (int q = 0; q < 8; ++q) { const float br = Bbar[(((size_t)dg * 64 + n) * 16 + p0 + q) * 2], bi = Bbar[(((size_t)dg * 64 + n) * 16 + p0 + q) * 2 + 1];
                v[q] = ri ? (wr_ * bi + wi_ * br) : (wr_ * br - wi_ * bi); }
            u32x4 w; w.x = pk2(v[0], v[1]); w.y = pk2(v[2], v[3]); w.z = pk2(v[4], v[5]); w.w = pk2(v[6], v[7]);
            *(GAS u32x4*)(ME_t + ((size_t)(g * 256 + o) * 256 + k8 * 8)) = w;
        }
        for (int idx = gtid; idx < 32 * 256 * 32; idx += NTH) {
            const int c8 = idx & 31, o = (idx >> 5) & 255, g = idx >> 13, j = o >> 4, p = o & 15;
            const int dir = c8 >> 4, ri = (c8 >> 3) & 1, n0 = (c8 & 7) * 8, dg = dir * 32 + g, e = dir ? 16 - j : j + 1;
            float v[8];
#pragma unroll
            for (int q = 0; q < 8; ++q) { const int n = n0 + q;
                const float wr_ = apow[((size_t)(dg * 17 + e) * 64 + n) * 2], wi_ = apow[((size_t)(dg * 17 + e) * 64 + n) * 2 + 1];
                const float cr = c_re[((size_t)dg * 16 + p) * 64 + n], ci = c_im[((size_t)dg * 16 + p) * 64 + n];
                v[q] = ri ? -(cr * wi_ + ci * wr_) : (cr * wr_ - ci * wi_); }
            u32x4 w; w.x = pk2(v[0], v[1]); w.y = pk2(v[2], v[3]); w.z = pk2(v[4], v[5]); w.w = pk2(v[6], v[7]);
            *(GAS u32x4*)(MY_t + ((size_t)(g * 256 + o) * 512 + 256 + c8 * 8)) = w;
        }
      }
        __syncthreads();
        PH(2) {
            pg8::Gemm g{H, Win_t, 1024, 1024, 1024}; pg8::SchedPlain S{TOK / 256, NPROJ / 256, G, bx, (size_t)256 * 1024 * 2, (size_t)256 * 1024 * 2};
            pg8::Epi8<FProj> E{FProj{Ap, P, CQR, ((const GAS float*)a.in[opq(I_BGATE)])}};
            pg8::gemm_phase(lds, g, S, E, wave);
        }
    }
    xcd_barrier(xbar, wave);

    {
      PHASE_BASES;
      PH(5) {
        const GAS float* qn = ((const GAS float*)a.in[opq(I_QNORM)]); const GAS float* kvn = ((const GAS float*)a.in[opq(I_KVNORM)]);
        const bool memwg = (G > 32) && (bx < 32);
        if (memwg) {
        PH(3) {
            pg8::Gemm g{MEMN, Wmk_t, 1024, 1024, 1024}; pg8::SchedPlain S{8, 2, G, bx, (size_t)256 * 1024 * 2, (size_t)256 * 1024 * 2};
            pg8::Epi8<FStore> E{FStore{Kmem, 512}};
            pg8::gemm_phase(lds, g, S, E, wave);
        }
        PH(4) {
            pg8::Gemm g{Wmv_t, MEMN, 1024, 1024, 1024}; pg8::SchedPlain S{2, 8, G, (bx + G - 16) % G, (size_t)256 * 1024 * 2, (size_t)256 * 1024 * 2};
            pg8::Epi8<FVtMem> E{FVtMem{Vtmem}};
            pg8::gemm_phase(lds, g, S, E, wave);
        }
        } else {
        const int gwr = ((G > 32) ? bx - 32 : bx) * 8 + wave, NGWR = ((G > 32) ? G - 32 : G) * 8;
        for (int t0 = gwr; t0 < TOK; t0 += 2 * NGWR) {
            const bool v1_ = t0 + NGWR < TOK;
            u32x2 wq[2]; unsigned wk[2]; float xs[2][4], xo[2][4], cs[2][4], sn[2][4];
            const int h = lane >> 3, d0 = (lane & 7) * 4;
#pragma unroll
            for (int rr = 0; rr < 2; ++rr) { const size_t t = (size_t)t0 + ((rr && v1_) ? (size_t)NGWR : 0); const GAS bf16_t* src = CQR + t * 512;
                wq[rr] = *(const GAS u32x2*)(src + lane * 4); wk[rr] = *(const GAS unsigned*)(src + 256 + lane * 2);
#pragma unroll
                for (int i = 0; i < 4; ++i) { const int d = d0 + i, dd = d & 15; xs[rr][i] = bf2f(src[384 + d]); xo[rr][i] = bf2f(src[384 + (d ^ 16)]);
                    cs[rr][i] = cosT[t * 16 + dd]; sn[rr][i] = sinT[t * 16 + dd]; } }
            const f32x4 gq = *(const GAS f32x4*)(qn + lane * 4); const float gk0 = kvn[lane * 2], gk1 = kvn[lane * 2 + 1];
            float x[2][4], y[2][2], sq[2], sk[2];
#pragma unroll
            for (int rr = 0; rr < 2; ++rr) { x[rr][0] = bf_lo(wq[rr].x); x[rr][1] = bf_hi(wq[rr].x); x[rr][2] = bf_lo(wq[rr].y); x[rr][3] = bf_hi(wq[rr].y);
                y[rr][0] = bf_lo(wk[rr]); y[rr][1] = bf_hi(wk[rr]);
                sq[rr] = x[rr][0] * x[rr][0] + x[rr][1] * x[rr][1] + x[rr][2] * x[rr][2] + x[rr][3] * x[rr][3]; sk[rr] = y[rr][0] * y[rr][0] + y[rr][1] * y[rr][1]; }
#pragma unroll
            for (int o = 1; o < 64; o <<= 1) { sq[0] += __shfl_xor(sq[0], o); sq[1] += __shfl_xor(sq[1], o); sk[0] += __shfl_xor(sk[0], o); sk[1] += __shfl_xor(sk[1], o); }
#pragma unroll
            for (int rr = 0; rr < 2; ++rr) { if (rr && !v1_) continue; const size_t t = (size_t)t0 + (size_t)rr * NGWR;
                const float rq = 1.f / sqrtf(sq[rr] * (1.f / 256.f) + NORM_EPS), rk = 1.f / sqrtf(sk[rr] * (1.f / 128.f) + NORM_EPS);
                u32x2 o; o.x = pk2(x[rr][0] * rq * gq.x, x[rr][1] * rq * gq.y); o.y = pk2(x[rr][2] * rq * gq.z, x[rr][3] * rq * gq.w);
                *(GAS u32x2*)(CQN + t * 256 + lane * 4) = o;
                *(GAS unsigned*)(CKVN + t * 128 + lane * 2) = pk2(y[rr][0] * rk * gk0, y[rr][1] * rk * gk1);
                float ov[4];
#pragma unroll
                for (int i = 0; i < 4; ++i) ov[i] = (d0 + i < 16) ? (xs[rr][i] * cs[rr][i] - xo[rr][i] * sn[rr][i]) : (xs[rr][i] * cs[rr][i] + xo[rr][i] * sn[rr][i]);
                u32x2 ok; ok.x = pk2(ov[0], ov[1]); ok.y = pk2(ov[2], ov[3]);
                *(GAS u32x2*)(Kbuf + t * 768 + h * 96 + 64 + d0) = ok; }
        }
        }
        { const GAS float* dsk = ((const GAS float*)a.in[opq(I_SSMD)]);
          for (int idx = gtid; idx < 32 * 256 * 32; idx += NTH) {
              const int k8 = idx & 31, o = (idx >> 5) & 255, g = idx >> 13, j = o >> 4, p = o & 15, j2 = k8 >> 1, q0 = (k8 & 1) * 8;
              float v[8];
#pragma unroll
              for (int q = 0; q < 8; ++q) { const int p2 = q0 + q; float x = 0.f;
                  if (j2 <= j) x += Kt[((size_t)(g * 16 + (j - j2))) * 256 + p * 16 + p2];
                  if (j2 >= j) x += Kt[((size_t)((32 + g) * 16 + (j2 - j))) * 256 + p * 16 + p2];
                  if (j2 == j && p2 == p) x += dsk[g * 16 + p];
                  v[q] = x; }
              u32x4 w; w.x = pk2(v[0], v[1]); w.y = pk2(v[2], v[3]); w.z = pk2(v[4], v[5]); w.w = pk2(v[6], v[7]);
              *(GAS u32x4*)(MY_t + ((size_t)(g * 256 + o) * 512 + k8 * 8)) = w;
          } }
      }
        PH(6) {
            pg8::Gemm g{Ap, ME_t, 512, 256, 256}; pg8::SchedBatch8 S{256, G, bx, (size_t)256 * 512 * 2, (size_t)256 * 256 * 2};
            pg8::Epi8<FStore> E{FStore{Eb, 256}};
            pg8::gemm_phase(lds, g, S, E, wave);
        }
    }
    xcd_barrier(xbar, wave);

    {
        PHASE_BASES;
        LAS float* tot = (LAS float*)lds;
        PH(7) for (int it2 = 2 * bx; it2 < 32 * 8 * 2; it2 += 2 * G) for (int it = it2; it < it2 + 2; ++it) {
            const int dir = it & 1, b = (it >> 1) & 7, g = it >> 4, dg = dir * 32 + g;
            const float aq_r = apow[((size_t)(dg * 17 + 16) * 64 + lane) * 2], aq_i = apow[((size_t)(dg * 17 + 16) * 64 + lane) * 2 + 1];
            float er[32], ei[32];
            const size_t rowbase = (size_t)g * 2048 + b * 256;
            const int c0 = dir ? 255 - wave * 32 : wave * 32; const long estr = dir ? -256 : 256, sstr = dir ? -512 : 512;
            const GAS bf16_t* ep0 = Eb + (rowbase + c0) * 256 + dir * 128 + lane;
            GAS bf16_t* sp0 = Ap + (rowbase + c0) * 512 + 256 + dir * 128 + lane;
#pragma unroll
            for (int k = 0; k < 32; ++k) { const GAS bf16_t* ep = ep0 + (long)k * estr; er[k] = bf2f(ep[0]); ei[k] = bf2f(ep[64]); }
            float sr = 0.f, si = 0.f;
#pragma unroll
            for (int k = 0; k < 32; ++k) { const float nr = aq_r * sr - aq_i * si + er[k], ni = aq_r * si + aq_i * sr + ei[k]; sr = nr; si = ni; }
            tot[(wave * 64 + lane) * 2] = sr; tot[(wave * 64 + lane) * 2 + 1] = si;
            float pr = aq_r, pi = aq_i;
#pragma unroll
            for (int s = 0; s < 5; ++s) { const float nr = pr * pr - pi * pi, ni = 2.f * pr * pi; pr = nr; pi = ni; }
            __syncthreads();
            sr = 0.f; si = 0.f;
            for (int w = 0; w < wave; ++w) { const float tr = tot[(w * 64 + lane) * 2], ti = tot[(w * 64 + lane) * 2 + 1];
                const float nr = pr * sr - pi * si + tr, ni = pr * si + pi * sr + ti; sr = nr; si = ni; }
#pragma unroll
            for (int k = 0; k < 32; ++k) { GAS bf16_t* sp = sp0 + (long)k * sstr;
                sp[0] = (bf16_t)(pk2(sr, 0.f) & 0xffffu); sp[64] = (bf16_t)(pk2(si, 0.f) & 0xffffu);
                const float nr = aq_r * sr - aq_i * si + er[k], ni = aq_r * si + aq_i * sr + ei[k]; sr = nr; si = ni; }
            __syncthreads();
        }
        asm volatile("s_waitcnt vmcnt(0)" ::: "memory"); __syncthreads();
        PH(13) {
            pg8::Gemm g{Ap, MY_t, 512, 512, 512}; pg8::SchedBatch8 S{256, G, bx, (size_t)256 * 512 * 2, (size_t)256 * 512 * 2};
            pg8::Epi8<FSsmY> E{FSsmY{Yb}};
            pg8::gemm_phase(lds, g, S, E, wave);
        }
        PH(8) {
            pg8::Gemm g{CQN, Wq_t, 256, 256, 256}; pg8::SchedPlain S{TOK / 256, 3, G, bx, (size_t)256 * 256 * 2, (size_t)256 * 256 * 2};
            EpiQ E{Qb, cosT, sinT};
            pg8::gemm_phase(lds, g, S, E, wave);
        }
        PH(9) {
            const bool kbal = (G == 256);
            pg8::Gemm g{CKVN, Wk_t, 128, 128, 128}; pg8::SchedPlain S{TOK / 256, 2, kbal ? 128 : G, kbal ? (bx >= 128 ? bx - 128 : (1 << 20)) : bx, (size_t)256 * 128 * 2, (size_t)256 * 128 * 2};
            pg8::Epi8<FKnope> E{FKnope{Kbuf}};
            pg8::gemm_phase(lds, g, S, E, wave);
        }
        PH(10) {
            pg8::Gemm g{Wv_t, CKVN, 128, 128, 128}; pg8::SchedPlain S{2, TOK / 256, G, bx, (size_t)256 * 128 * 2, (size_t)256 * 128 * 2};
            pg8::Epi8<FVt> E{FVt{Vt}};
            pg8::gemm_phase(lds, g, S, E, wave);
        }
    }
    xcd_barrier(xbar, wave);

    {
        PHASE_BASES;
        if (wave >= 4) __builtin_amdgcn_s_setprio(1);
        PH(11) for (int L = vcu; L < 8 * 8 * 16; L += G) {
            const int qb = L & 15, bh = L >> 4, b = bh >> 3, h = bh & 7; const size_t row0 = (size_t)b * SEQ + qb * 256;
            attn_unit<96, 64, 1, true>(lds, Qb + row0 * 768 + h * 96, 768, Kbuf + (size_t)b * SEQ * 768 + h * 96, 768,
                              Vt + (size_t)(b * 512 + h * 64) * 4096, 4096, SEQ, P + row0 * PW + PC_ZMLA + h * 64, P + row0 * PW + PC_ZMLA + h * 64, PW, wave);
        }
        PH(12) for (int L = vcu; L < 8 * 4 * 16; L += G) {
            const int qb = L & 15, bh = L >> 4, b = bh >> 2, h = bh & 3; const size_t row0 = (size_t)b * SEQ + qb * 256;
            attn_unit<128, 128, 1, false>(lds, P + row0 * PW + PC_QMEM + h * 128, PW, Kmem + (size_t)b * 256 * 512 + h * 128, 512,
                                Vtmem + (size_t)(b * 512 + h * 128) * 256, 256, 256, P + row0 * PW + PC_ZMEM + h * 128, P + row0 * PW + PC_ZMEM + h * 128, PW, wave);
        }
        __builtin_amdgcn_s_setprio(0);
        PH(14) {
            pg8::Gemm g{Yb, Wglu_t, 512, 512, 512}; pg8::SchedPlain S{TOK / 256, 2, G, bx, (size_t)256 * 512 * 2, (size_t)256 * 512 * 2};
            pg8::Epi8<FGlu> E{FGlu{Yb, P, ((const GAS float*)a.in[opq(I_GLUB)])}};
            pg8::gemm_phase(lds, g, S, E, wave);
        }
    }
    xcd_barrier(xbar, wave);

    PH(15) {
        PHASE_BASES;
        pg8::Gemm g{P, Wbr_t, PW, 1536, 1536}; pg8::SchedPlain S{TOK / 256, 4, G, bx, (size_t)256 * PW * 2, (size_t)256 * 1536 * 2};
        EpiBranchH E{P, Mg};
        pg8::gemm_phase(lds, g, S, E, wave);
    }
    xcd_barrier(xbar, wave);

    if (G == 256) {
        PHASE_BASES;
        LAS float* rsq = (LAS float*)(lds + 131072 + 1024);
        LAS float* tot = rsq + 8 * 256;
        {
            pg8::Gemm g{Mg, Wout_t, 1024, 1024, 1024}; pg8::SchedPair S{bx, (size_t)256 * 1024 * 2, (size_t)256 * 1024 * 2};
            EpiOutRS E{OUTB, rsq};
            pg8::gemm_phase(lds, g, S, E, wave);
        }
        asm volatile("s_waitcnt vmcnt(0) lgkmcnt(0)" ::: "memory"); __syncthreads();
        float* xch = (float*)(a.ws + WS_CTL + 65536);
        unsigned* flg = (unsigned*)(a.ws + WS_CTL) + 3520;
        if (tid < 256) { float sv = 0.f;
#pragma unroll
            for (int k = 0; k < 8; ++k) sv += rsq[k * 256 + tid];
            tot[tid] = sv; __hip_atomic_store(xch + bx * 256 + tid, sv, __ATOMIC_RELAXED, __HIP_MEMORY_SCOPE_AGENT); }
        asm volatile("s_waitcnt vmcnt(0) lgkmcnt(0)" ::: "memory"); __syncthreads();
        if (tid == 0) {
            __hip_atomic_store(flg + bx, 1u, __ATOMIC_RELAXED, __HIP_MEMORY_SCOPE_AGENT);
            unsigned sp = 0u; while (__hip_atomic_load(flg + (bx ^ 1), __ATOMIC_RELAXED, __HIP_MEMORY_SCOPE_AGENT) == 0u) { __builtin_amdgcn_s_sleep(1); if (++sp > (1u << 22)) break; }
            __builtin_amdgcn_fence(__ATOMIC_ACQUIRE, "agent");
        }
        __syncthreads();
        if (tid < 256) { const float spv = __hip_atomic_load(xch + (bx ^ 1) * 256 + tid, __ATOMIC_RELAXED, __HIP_MEMORY_SCOPE_AGENT);
            tot[tid] = 1.f / sqrtf((tot[tid] + spv) * (1.f / 1024.f) + NORM_EPS); }
        __syncthreads();
        {
            const GAS float* x = ((const GAS float*)a.in[opq(I_X)]); const GAS float* pn = ((const GAS float*)a.in[opq(I_POSTNORM)]);
            const int cb = (bx & 1) * 512 + lane * 8; const size_t row0 = (size_t)(bx >> 1) * 256 + wave * 32;
            const f32x4 g0 = *(const GAS f32x4*)(pn + cb), g1 = *(const GAS f32x4*)(pn + cb + 4);
            for (int rr = 0; rr < 32; rr += 4) {
                u32x4 ow[4]; f32x4 x0[4], x1[4];
#pragma unroll
                for (int k = 0; k < 4; ++k) { const size_t off = (row0 + rr + k) * 1024 + cb; ow[k] = *(const GAS u32x4*)(OUTB + off);
                    x0[k] = __builtin_nontemporal_load((const GAS f32x4*)(x + off)); x1[k] = __builtin_nontemporal_load((const GAS f32x4*)(x + off + 4)); }
#pragma unroll
                for (int k = 0; k < 4; ++k) { const size_t off = (row0 + rr + k) * 1024 + cb; const float rstd = tot[wave * 32 + rr + k];
                    f32x4 lo, hi; unpack8(ow[k], lo, hi);
                    __builtin_nontemporal_store(x0[k] + lo * rstd * g0, (GAS f32x4*)(((GAS float*)a.out) + off));
                    __builtin_nontemporal_store(x1[k] + hi * rstd * g1, (GAS f32x4*)(((GAS float*)a.out) + off + 4)); }
            }
        }
    } else {
    PH(16) {
        PHASE_BASES;
        pg8::Gemm g{Mg, Wout_t, 1024, 1024, 1024}; pg8::SchedPlain S{TOK / 256, 4, G, bx, (size_t)256 * 1024 * 2, (size_t)256 * 1024 * 2};
        pg8::Epi8<FStore> E{FStore{OUTB, 1024}};
        pg8::gemm_phase(lds, g, S, E, wave);
    }
    xcd_barrier(xbar, wave);
    PH(17) {
        PHASE_BASES;
        const GAS float* x = ((const GAS float*)a.in[opq(I_X)]); const GAS float* pn = ((const GAS float*)a.in[opq(I_POSTNORM)]);
        for (int m0 = gw; m0 < TOK; m0 += 2 * NGW) {
            u32x4 ow[2][2]; f32x4 xv[2][4];
#pragma unroll
            for (int rr = 0; rr < 2; ++rr) { const size_t m = (size_t)m0 + (size_t)rr * NGW;
#pragma unroll
                for (int j = 0; j < 2; ++j) { ow[rr][j] = *(const GAS u32x4*)(OUTB + m * 1024 + j * 512 + lane * 8);
                    xv[rr][2 * j] = __builtin_nontemporal_load((const GAS f32x4*)(x + m * 1024 + j * 512 + lane * 8)); xv[rr][2 * j + 1] = __builtin_nontemporal_load((const GAS f32x4*)(x + m * 1024 + j * 512 + lane * 8 + 4)); } }
            f32x4 v[2][4]; float s[2];
#pragma unroll
            for (int rr = 0; rr < 2; ++rr) { s[rr] = 0.f;
#pragma unroll
                for (int j = 0; j < 2; ++j) { f32x4 lo, hi; unpack8(ow[rr][j], lo, hi); v[rr][2 * j] = lo; v[rr][2 * j + 1] = hi;
                    s[rr] += (lo.x * lo.x + lo.y * lo.y) + (lo.z * lo.z + lo.w * lo.w) + (hi.x * hi.x + hi.y * hi.y) + (hi.z * hi.z + hi.w * hi.w); } }
#pragma unroll
            for (int o = 1; o < 64; o <<= 1) { s[0] += __shfl_xor(s[0], o); s[1] += __shfl_xor(s[1], o); }
#pragma unroll
            for (int rr = 0; rr < 2; ++rr) { const size_t m = (size_t)m0 + (size_t)rr * NGW; const float rstd = 1.f / sqrtf(s[rr] * (1.f / 1024.f) + NORM_EPS);
#pragma unroll
                for (int q = 0; q < 4; ++q) { const int c = (q >> 1) * 512 + lane * 8 + (q & 1) * 4; const f32x4 gv = *(const GAS f32x4*)(pn + c);
                    __builtin_nontemporal_store(xv[rr][q] + v[rr][q] * rstd * gv, (GAS f32x4*)(((GAS float*)a.out) + m * 1024 + c)); } }
        }
    }
    }
}

extern "C" void kernel_launch(void* const* d_in, const int* in_sizes, int n_in, void* d_out, int out_size, void* d_ws, size_t ws_size, hipStream_t stream) {
    static int grid = 0;
    if (grid == 0) {
        if (n_in != 27 || out_size != TOK * DM || ws_size < WS_END) { fprintf(stderr, "kernel_launch: unexpected problem shape (n_in %d, out %d, ws %zu)\n", n_in, out_size, ws_size); grid = -1; return; }
        int dev = 0, cus = 0, per_cu = 0;
        hipGetDevice(&dev); hipDeviceGetAttribute(&cus, hipDeviceAttributeMultiprocessorCount, dev);
        if (hipFuncSetAttribute((const void*)fwd_mega, hipFuncAttributeMaxDynamicSharedMemorySize, LDS_BYTES) != hipSuccess) { fprintf(stderr, "hipFuncSetAttribute failed\n"); grid = -1; return; }
        if (hipOccupancyMaxActiveBlocksPerMultiprocessor(&per_cu, (const void*)fwd_mega, 512, LDS_BYTES) != hipSuccess || per_cu < 1) { fprintf(stderr, "occupancy query: %d\n", per_cu); per_cu = 1; }
        (void)hipGetLastError();
        grid = cus * 1;
    }
    if (grid < 0) return;
    if (hipMemsetAsync((char*)d_ws + WS_CTL, 0, CTL_BYTES, stream) != hipSuccess) { fprintf(stderr, "memset of barrier words failed\n"); return; }
    Args a{};
    for (int i = 0; i < 27; ++i) a.in[i] = (const float*)d_in[i];
    a.out = (float*)d_out; a.ws = (unsigned char*)d_ws;
    void* args[] = {&a};
    hipError_t e = hipLaunchCooperativeKernel((const void*)fwd_mega, dim3(grid), dim3(512), args, LDS_BYTES, stream);
    if (e != hipSuccess) fprintf(stderr, "cooperative launch failed: %s (grid %d)\n", hipGetErrorString(e), grid);
}
```

```cpp
#include <hip/hip_runtime.h>
#include <hip/hip_cooperative_groups.h>
#include <cstdio>
#include <cstdint>
namespace cg = cooperative_groups;

#define LAS __attribute__((address_space(3)))
#define GAS __attribute__((address_space(1)))
typedef unsigned short bf16_t;
typedef short bf16x8 __attribute__((ext_vector_type(8)));
typedef float f32x4 __attribute__((ext_vector_type(4)));
typedef float f32x16 __attribute__((ext_vector_type(16)));
typedef unsigned u32x4 __attribute__((ext_vector_type(4)));
typedef unsigned u32x2 __attribute__((ext_vector_type(2)));

constexpr int TOK = 32768, DM = 1024, SEQ = 4096, NB = 8;
constexpr int NPROJ = 6144;
constexpr int PW = 5120;
constexpr int PC_ZSSM = 0, PC_ZMLA = 512, PC_ZMEM = 1024, PC_QMEM = 1536, PC_GATE = 2048;
constexpr float LOG2E = 1.4426950408889634f;
constexpr float NORM_EPS = 1e-6f;

constexpr size_t MiB = 1u << 20;
constexpr size_t WS_WIN = 0;
constexpr size_t WS_WGLU = 12 * MiB;
constexpr size_t WS_WQ = WS_WGLU + 512 * 1024;
constexpr size_t WS_WK = WS_WQ + 384 * 1024;
constexpr size_t WS_WV = WS_WK + 128 * 1024;
constexpr size_t WS_WMK = 14 * MiB;
constexpr size_t WS_WMV = 15 * MiB;
constexpr size_t WS_WBR = 16 * MiB;
constexpr size_t WS_WOUT = 19 * MiB;
constexpr size_t WS_MET = 21 * MiB;
constexpr size_t WS_MYT = 25 * MiB;
constexpr size_t WS_COS = 33 * MiB;
constexpr size_t WS_SIN = 35 * MiB;
constexpr size_t WS_APOW = 37 * MiB;
constexpr size_t WS_BBAR = 38 * MiB;
constexpr size_t WS_KT = 39 * MiB;
constexpr size_t WS_KMEM = 40 * MiB;
constexpr size_t WS_VTMEM = 42 * MiB;
constexpr size_t WS_CTL = 44 * MiB, CTL_BYTES = 16384;
constexpr size_t WS_P = 48 * MiB;
constexpr size_t WS_CQR = 368 * MiB;
constexpr size_t WS_VT = WS_CQR;
constexpr size_t WS_AP = 400 * MiB;
constexpr size_t WS_OUT = WS_P;
constexpr size_t WS_MG = 368 * MiB;
constexpr size_t WS_CQN = 464 * MiB;
constexpr size_t WS_CKVN = 0;
constexpr size_t WS_Y = 480 * MiB;
constexpr size_t WS_END = 512 * MiB;
constexpr size_t DO_H = 0;
constexpr size_t DO_MEMN = 64 * MiB;
constexpr size_t DO_E = 0;
constexpr size_t DO_KBUF = 32 * MiB;
constexpr size_t DO_QB = 80 * MiB;
constexpr size_t DO_Y = 0;
constexpr size_t DO_MERGED = 0;

__device__ __forceinline__ unsigned pk2(float lo, float hi) {
    typedef float f2 __attribute__((ext_vector_type(2))); typedef __bf16 b2 __attribute__((ext_vector_type(2)));
    f2 v = {lo, hi}; b2 b = __builtin_convertvector(v, b2); return __builtin_bit_cast(unsigned, b);
}
__device__ __forceinline__ float bf_lo(unsigned w) { return __uint_as_float(w << 16); }
__device__ __forceinline__ float bf_hi(unsigned w) { return __uint_as_float(w & 0xffff0000u); }
__device__ __forceinline__ float bf2f(bf16_t h) { return __uint_as_float((unsigned)h << 16); }
__device__ __forceinline__ float fexp2(float x) { return __builtin_amdgcn_exp2f(x); }
__device__ __forceinline__ float frcp(float x) { return __builtin_amdgcn_rcpf(x); }
__device__ __forceinline__ float sigmoidf_(float x) { return frcp(1.f + fexp2(-x * LOG2E)); }
__device__ __forceinline__ float siluf_(float x) { return x * sigmoidf_(x); }
__device__ __forceinline__ float gelu_tanh(float x) { const float u = 0.7978845608028654f * (x + 0.044715f * x * x * x); return x * sigmoidf_(2.f * u); }
__device__ __forceinline__ int lane_id_() { return (int)__builtin_amdgcn_mbcnt_hi(~0u, __builtin_amdgcn_mbcnt_lo(~0u, 0u)); }
__device__ __forceinline__ float wave_sum(float v) {
#pragma unroll
    for (int o = 1; o < 64; o <<= 1) v += __shfl_xor(v, o);
    return v;
}
__device__ __forceinline__ void sincos_red(double ang, float& s, float& c) {
    const double k = rint(ang * 0.15915494309189535);
    const float r = (float)(ang - k * 6.283185307179586);
    s = sinf(r); c = cosf(r);
}

namespace pg8 {
constexpr int BM = 256, BK = 64, HALF = 128, HTB = HALF * BK * 2, STAGE_BYTES = 8 * HTB, NXCD = 8, WGM = 8;
__host__ __device__ __forceinline__ int lds_byte(int r, int c) { const int st = (r >> 4) * 2 + (c >> 5), rr = r & 15, cc = c & 31, ob = rr * 64 + cc * 2; return st * 1024 + (ob ^ (((ob >> 9) & 1) << 5)); }
__host__ __device__ __forceinline__ void stage_rc(int b, int& R, int& C) { const int st = b / 1024, sb = b % 1024, swz = sb ^ (((sb >> 9) & 1) << 5); R = (st >> 1) * 16 + swz / 64; C = (st & 1) * 32 + (swz % 64) / 2; }
__host__ __device__ __forceinline__ int perm32(int rho) { const int n = rho >> 4, i = rho & 15; return 8 * (i >> 2) + 4 * n + (i & 3); }

struct Unit { int pm, pn, aux, pad_; size_t aoff, boff; };
struct Gemm { const GAS bf16_t* A; const GAS bf16_t* Bt; int lda, ldb, K; };

__device__ __forceinline__ bool tile_order(long L, int nM, int nN, int& pm, int& pn) {
    const int nwg = nM * nN; if (L >= nwg) return false;
    int wgid = (int)L; { const int q = nwg / NXCD, r = nwg % NXCD, xcd = wgid % NXCD, off = wgid / NXCD; wgid = (xcd < r ? xcd * (q + 1) : r * (q + 1) + (xcd - r) * q) + off; }
    const int nig = WGM * nN, gid = wgid / nig, fm = gid * WGM, gsz = (nM - fm) < WGM ? (nM - fm) : WGM;
    pm = fm + ((wgid % nig) % gsz); pn = (wgid % nig) / gsz; return true;
}
struct SchedPlain {
    int nM, nN, G, c; size_t astep, bstep;
    __device__ __forceinline__ bool next(int i, Unit& u) const {
        if (!tile_order((long)i * G + c, nM, nN, u.pm, u.pn)) return false;
        u.aux = 0; u.pad_ = 0; u.aoff = (size_t)u.pm * astep; u.boff = (size_t)u.pn * bstep; return true; }
};
struct SchedBatch8 {
    int nM, G, c; size_t astep, bstep;
    __device__ __forceinline__ bool next(int i, Unit& u) const {
        const long L = (long)i * G + c; if (L >= nM) return false;
        u.pm = (int)L; u.pn = 0; u.aux = 0; u.pad_ = 0; u.aoff = (size_t)u.pm * astep; u.boff = (size_t)(u.pm >> 3) * bstep; return true; }
};
struct SchedPair {
    int c; size_t astep, bstep;
    __device__ __forceinline__ bool next(int i, Unit& u) const {
        if (i >= 2) return false;
        u.pm = c >> 1; u.pn = 2 * (c & 1) + i; u.aux = i; u.pad_ = 0; u.aoff = (size_t)u.pm * astep; u.boff = (size_t)u.pn * bstep; return true; }
};
struct SchedBranch {
    int nM, nN, G, c; size_t astep, bstep;
    __device__ __forceinline__ bool next(int i, Unit& u) const {
        const int seg = i % 3, it = i / 3;
        if (!tile_order((long)it * G + c, nM, nN, u.pm, u.pn)) return false;
        u.aux = seg; u.pad_ = 0; u.aoff = (size_t)u.pm * astep + (size_t)(seg == 0 ? PC_ZSSM * 2 : (seg == 1 ? PC_ZMLA * 2 : PC_ZMEM * 2)); u.boff = (size_t)(seg * nN + u.pn) * bstep; return true; }
};

template <class Epi, class Sched>
__device__ __forceinline__ void gemm_phase(LAS unsigned char* lds, const Gemm g, const Sched& S, const Epi& E, const int wave_) {
    int lane_ = lane_id_(); asm volatile("" : "+v"(lane_));
    const int lane = lane_, wid = wave_, tid = wave_ * 64 + lane, wr = wid >> 2, wc = wid & 3, fr = lane & 15, fq = lane >> 4;
    int K_ = g.K; asm volatile("" : "+s"(K_));
    const int K = K_, nt = K / BK;
    unsigned voffA[2], voffB[2];
#pragma unroll
    for (int i = 0; i < 2; ++i) { int R, C; stage_rc(tid * 16 + i * 8192, R, C); const int Rb = Epi::PERM ? ((R & ~31) + perm32(R & 31)) : R;
        voffA[i] = (unsigned)(R * g.lda + C) * 2u; voffB[i] = (unsigned)(Rb * g.ldb + C) * 2u; }
    const size_t kstep = (size_t)(BK * 2);
    const size_t hstepA = (size_t)HALF * g.lda * 2, hstepB = (size_t)HALF * g.ldb * 2;
    const unsigned ldsw = (unsigned)wid * 1024u;
    const int aoff = lds_byte(wr * 64 + fr, fq * 8), boff = lds_byte(wc * 32 + fr, fq * 8);
#define PG8_SA(b, h) (((b) * 2 + (h)) * HTB)
#define PG8_SB(b, h) ((4 + (b) * 2 + (h)) * HTB)
#define PG8_STAGE(bufoff, gbase, voff) do { _Pragma("unroll") for (int _i = 0; _i < 2; ++_i) \
        __builtin_amdgcn_global_load_lds((const GAS unsigned*)((const char*)(gbase) + (voff)[_i]), (LAS unsigned*)(lds + (bufoff) + ldsw + _i * 8192), 16, 0, 0); } while (0)
#define PG8_LDA(dst, b, h) do { _Pragma("unroll") for (int m = 0; m < 4; ++m) _Pragma("unroll") for (int k = 0; k < 2; ++k) dst[m][k] = *(const LAS bf16x8*)(lds + PG8_SA(b, h) + aoff + m * 2048 + k * 1024); } while (0)
#define PG8_LDB(dst, b, h) do { _Pragma("unroll") for (int n = 0; n < 2; ++n) _Pragma("unroll") for (int k = 0; k < 2; ++k) dst[n][k] = *(const LAS bf16x8*)(lds + PG8_SB(b, h) + boff + n * 2048 + k * 1024); } while (0)
#define PG8_MMA(ai, bj, At, Bt) do { __builtin_amdgcn_s_setprio(1); _Pragma("unroll") for (int m = 0; m < 4; ++m) _Pragma("unroll") for (int n = 0; n < 2; ++n) _Pragma("unroll") for (int k = 0; k < 2; ++k) \
        acc[ai][bj][m][n] = __builtin_amdgcn_mfma_f32_16x16x32_bf16(Bt[n][k], At[m][k], acc[ai][bj][m][n], 0, 0, 0); __builtin_amdgcn_s_setprio(0); } while (0)
#define PG8_WAIT_V(n) asm volatile("s_waitcnt vmcnt(" #n ")" ::: "memory")
#define PG8_WAIT_L(n) asm volatile("s_waitcnt lgkmcnt(" #n ")" ::: "memory")
#define PG8_BAR __builtin_amdgcn_s_barrier()
#define PG8_SCHED __builtin_amdgcn_sched_barrier(0)
    Unit cur, nxt; int ui = 0;
    if (!S.next(0, cur)) return;
    f32x4 acc[2][2][4][2];
#pragma unroll
    for (int a = 0; a < 2; ++a)
#pragma unroll
        for (int b = 0; b < 2; ++b)
#pragma unroll
            for (int m = 0; m < 4; ++m)
#pragma unroll
                for (int n = 0; n < 2; ++n) acc[a][b][m][n] = (f32x4){0.f, 0.f, 0.f, 0.f};
    bf16x8 At[4][2], B0[2][2], B1[2][2];
    const char* cA = (const char*)g.A + cur.aoff; const char* cB = (const char*)g.Bt + cur.boff;
    {
        PG8_STAGE(PG8_SB(0, 0), cB, voffB); PG8_STAGE(PG8_SB(0, 1), cB + hstepB, voffB); PG8_STAGE(PG8_SA(0, 0), cA, voffA); PG8_STAGE(PG8_SA(0, 1), cA + hstepA, voffA);
        if (wr == 1) PG8_BAR;
        PG8_WAIT_V(2); PG8_BAR;
        PG8_STAGE(PG8_SB(1, 0), cB + kstep, voffB); PG8_STAGE(PG8_SA(1, 0), cA + kstep, voffA); PG8_STAGE(PG8_SB(1, 1), cB + hstepB + kstep, voffB);
        PG8_WAIT_V(6); PG8_BAR;
    }
    for (;;) {
        const bool has_next = S.next(ui + 1, nxt);
        const char* nA = has_next ? (const char*)g.A + nxt.aoff : cA; const char* nB = has_next ? (const char*)g.Bt + nxt.boff : cB;
#pragma unroll 1
        for (int t = 0; t < nt; t += 2) {
            if constexpr (Epi::HOOK) { if (t == 8 || t == 16) { E.hook(acc, cur, t >> 3, wr, wc, fr, fq); PG8_WAIT_V(0); } }
            const bool last = (t == nt - 2);
            const char* a1 = cA + (size_t)(t + 1) * kstep;
            const char* a2 = last ? nA : cA + (size_t)(t + 2) * kstep; const char* b2 = last ? nB : cB + (size_t)(t + 2) * kstep;
            const char* a3 = a2 + kstep; const char* b3 = b2 + kstep;
            PG8_LDB(B0, 0, 0); PG8_LDB(B1, 0, 1); PG8_SCHED; PG8_LDA(At, 0, 0); PG8_STAGE(PG8_SA(1, 1), a1 + hstepA, voffA);
            PG8_WAIT_V(8); PG8_WAIT_L(0); PG8_BAR; PG8_MMA(0, 0, At, B0); PG8_MMA(0, 1, At, B1); PG8_BAR; PG8_SCHED;
            PG8_LDA(At, 0, 1); PG8_STAGE(PG8_SB(0, 0), b2, voffB); PG8_STAGE(PG8_SB(0, 1), b2 + hstepB, voffB); PG8_STAGE(PG8_SA(0, 0), a2, voffA);
            PG8_WAIT_V(8); PG8_WAIT_L(0); PG8_BAR; PG8_MMA(1, 0, At, B0); PG8_MMA(1, 1, At, B1); PG8_BAR; PG8_SCHED;
            PG8_LDB(B0, 1, 0); PG8_LDB(B1, 1, 1); PG8_SCHED; PG8_LDA(At, 1, 0); PG8_STAGE(PG8_SA(0, 1), a2 + hstepA, voffA);
            PG8_WAIT_V(8); PG8_WAIT_L(0); PG8_BAR; PG8_MMA(0, 0, At, B0); PG8_MMA(0, 1, At, B1); PG8_BAR; PG8_SCHED;
            PG8_LDA(At, 1, 1); PG8_STAGE(PG8_SB(1, 0), b3, voffB); PG8_STAGE(PG8_SB(1, 1), b3 + hstepB, voffB); PG8_STAGE(PG8_SA(1, 0), a3, voffA);
            PG8_WAIT_V(8); PG8_WAIT_L(0); PG8_BAR; PG8_MMA(1, 0, At, B0); PG8_MMA(1, 1, At, B1); PG8_BAR; PG8_SCHED;
        }
        if (wr == 0) PG8_BAR;
        E(acc, cur, wr, wc, fr, fq);
        if (!has_next) break;
#pragma unroll
        for (int a = 0; a < 2; ++a)
#pragma unroll
            for (int b = 0; b < 2; ++b)
#pragma unroll
                for (int m = 0; m < 4; ++m)
#pragma unroll
                    for (int n = 0; n < 2; ++n) acc[a][b][m][n] = (f32x4){0.f, 0.f, 0.f, 0.f};
        cur = nxt; cA = nA; cB = nB; ++ui;
        if (wr == 1) PG8_BAR;
    }
    PG8_WAIT_V(0);
    PG8_BAR;
#undef PG8_SA
#undef PG8_SB
#undef PG8_STAGE
#undef PG8_LDA
#undef PG8_LDB
#undef PG8_MMA
#undef PG8_WAIT_V
#undef PG8_WAIT_L
#undef PG8_BAR
#undef PG8_SCHED
}

template <class F> struct Epi8 {
    static constexpr bool PERM = true, HOOK = false;
    F f;
    __device__ __forceinline__ void operator()(const f32x4 (&acc)[2][2][4][2], const Unit& u, int wr, int wc, int fr, int fq) const {
#pragma unroll
        for (int ai = 0; ai < 2; ++ai)
#pragma unroll
            for (int m = 0; m < 4; ++m) {
                const int row = u.pm * BM + ai * HALF + wr * 64 + m * 16 + fr;
#pragma unroll
                for (int bj = 0; bj < 2; ++bj) f(u, row, bj * HALF + wc * 32 + 8 * fq, acc[ai][bj][m][0], acc[ai][bj][m][1]);
            }
    }
};
}
using pg8::Unit;

__device__ __forceinline__ u32x4 pack8(f32x4 a, f32x4 b) { u32x4 w; w.x = pk2(a[0], a[1]); w.y = pk2(a[2], a[3]); w.z = pk2(b[0], b[1]); w.w = pk2(b[2], b[3]); return w; }
__device__ __forceinline__ void unpack8(u32x4 w, f32x4& a, f32x4& b) { a = (f32x4){bf_lo(w.x), bf_hi(w.x), bf_lo(w.y), bf_hi(w.y)}; b = (f32x4){bf_lo(w.z), bf_hi(w.z), bf_lo(w.w), bf_hi(w.w)}; }

struct FProj {
    GAS bf16_t* Ap; GAS bf16_t* P; GAS bf16_t* CQR; const GAS float* b_gate;
    __device__ __forceinline__ void operator()(const Unit& u, int row, int col, f32x4 v0, f32x4 v1) const {
        const int pn = u.pn;
        if (pn < 2) {
            const int c = pn * 256 + col, g = c >> 4, p = c & 15;
            *(GAS u32x4*)(Ap + ((size_t)(g * 2048 + (row >> 4)) * 512 + (row & 15) * 16 + p)) = pack8(v0, v1);
        } else if (pn < 22) {
            const int pc = pn * 256 - 512 + col;
            if (pn >= 10) {
                const f32x4 b0 = *(const GAS f32x4*)(b_gate + pc - PC_GATE), b1 = *(const GAS f32x4*)(b_gate + pc - PC_GATE + 4);
#pragma unroll
                for (int i = 0; i < 4; ++i) { v0[i] = sigmoidf_(v0[i] + b0[i]); v1[i] = sigmoidf_(v1[i] + b1[i]); }
            } else if (pn == 8 || pn == 9) {
                const float sc = 0.08838834764831845f * LOG2E;
                v0 = v0 * sc; v1 = v1 * sc;
            } else {
#pragma unroll
                for (int i = 0; i < 4; ++i) { v0[i] = siluf_(v0[i]); v1[i] = siluf_(v1[i]); }
            }
            *(GAS u32x4*)(P + (size_t)row * PW + pc) = pack8(v0, v1);
        } else {
            *(GAS u32x4*)(CQR + (size_t)row * 512 + (pn - 22) * 256 + col) = pack8(v0, v1);
        }
    }
};
struct FStore {
    GAS bf16_t* O; int ldc;
    __device__ __forceinline__ void operator()(const Unit& u, int row, int col, f32x4 v0, f32x4 v1) const {
        *(GAS u32x4*)(O + (size_t)row * ldc + u.pn * 256 + col) = pack8(v0, v1);
    }
};
struct FVtMem {
    GAS bf16_t* O;
    __device__ __forceinline__ void operator()(const Unit& u, int row, int col, f32x4 v0, f32x4 v1) const {
        *(GAS u32x4*)(O + ((size_t)(u.pn * 512 + row) * 256 + col)) = pack8(v0, v1);
    }
};
struct FKnope {
    GAS bf16_t* O;
    __device__ __forceinline__ void operator()(const Unit& u, int row, int col, f32x4 v0, f32x4 v1) const {
        const int c = u.pn * 256 + col;
        *(GAS u32x4*)(O + (size_t)row * 768 + (c >> 6) * 96 + (c & 63)) = pack8(v0, v1);
    }
};
struct FVt {
    GAS bf16_t* O;
    __device__ __forceinline__ void operator()(const Unit& u, int row, int col, f32x4 v0, f32x4 v1) const {
        const int b = u.pn >> 4, tl = (u.pn & 15) * 256 + col;
        *(GAS u32x4*)(O + ((size_t)(b * 512 + row) * 4096 + tl)) = pack8(v0, v1);
    }
};
struct FSsmY {
    GAS bf16_t* Y;
    __device__ __forceinline__ void operator()(const Unit& u, int row, int col, f32x4 v0, f32x4 v1) const {
        const int g = row >> 11, rowg = row & 2047, j = col >> 4, p = col & 15;
#pragma unroll
        for (int i = 0; i < 4; ++i) { v0[i] = gelu_tanh(v0[i]); v1[i] = gelu_tanh(v1[i]); }
        *(GAS u32x4*)(Y + ((size_t)(rowg * 16 + j) * 512 + g * 16 + p)) = pack8(v0, v1);
    }
};
struct FGlu {
    const GAS bf16_t* Y; GAS bf16_t* P; const GAS float* glu_b;
    __device__ __forceinline__ void operator()(const Unit& u, int row, int col, f32x4 v0, f32x4 v1) const {
        const int c = u.pn * 256 + col;
        const f32x4 b0 = *(const GAS f32x4*)(glu_b + c), b1 = *(const GAS f32x4*)(glu_b + c + 4);
        f32x4 y0, y1, z0, z1; unpack8(*(const GAS u32x4*)(Y + (size_t)row * 512 + c), y0, y1);
        GAS bf16_t* zp = P + (size_t)row * PW + PC_ZSSM + c; unpack8(*(const GAS u32x4*)zp, z0, z1);
#pragma unroll
        for (int i = 0; i < 4; ++i) { v0[i] = y0[i] * sigmoidf_(v0[i] + b0[i]) * z0[i]; v1[i] = y1[i] * sigmoidf_(v1[i] + b1[i]) * z1[i]; }
        *(GAS u32x4*)zp = pack8(v0, v1);
    }
};
struct FBranch {
    const GAS bf16_t* P; GAS bf16_t* Mg;
    __device__ __forceinline__ void operator()(const Unit& u, int row, int col, f32x4 v0, f32x4 v1) const {
        const int c = u.pn * 256 + col, seg = u.aux;
        f32x4 g0, g1; unpack8(*(const GAS u32x4*)(P + (size_t)row * PW + PC_GATE + seg * 1024 + c), g0, g1);
        GAS bf16_t* mp = Mg + (size_t)row * 1024 + c;
        v0 = v0 * g0; v1 = v1 * g1;
        if (seg != 0) { f32x4 m0, m1; unpack8(*(const GAS u32x4*)mp, m0, m1); v0 = v0 + m0; v1 = v1 + m1; }
        *(GAS u32x4*)mp = pack8(v0, v1);
    }
};
struct EpiBranchH {
    static constexpr bool PERM = true, HOOK = true;
    const GAS bf16_t* Pg; GAS bf16_t* Mgp;
    __device__ __forceinline__ void hook(f32x4 (&acc)[2][2][4][2], const Unit& u, int seg, int wr, int wc, int fr, int fq) const {
        const GAS bf16_t* gbase = Pg + (size_t)(u.pm * 256 + wr * 64 + fr) * PW + PC_GATE + (seg - 1) * 1024 + u.pn * 256 + wc * 32 + 8 * fq;
#pragma unroll
        for (int ai = 0; ai < 2; ++ai) {
            u32x4 ga[4][2], gb[4][2];
#pragma unroll
            for (int m = 0; m < 4; ++m)
#pragma unroll
                for (int bj = 0; bj < 2; ++bj) { const GAS bf16_t* gp = gbase + (size_t)(ai * 128 + m * 16) * PW + bj * 128;
                    ga[m][bj] = *(const GAS u32x4*)gp; gb[m][bj] = *(const GAS u32x4*)(gp + 1024); }
#pragma unroll
            for (int m = 0; m < 4; ++m)
#pragma unroll
                for (int bj = 0; bj < 2; ++bj) { f32x4 a0, a1, b0, b1; unpack8(ga[m][bj], a0, a1); unpack8(gb[m][bj], b0, b1);
#pragma unroll
                    for (int i = 0; i < 4; ++i) { acc[ai][bj][m][0][i] *= a0[i] * frcp(b0[i]); acc[ai][bj][m][1][i] *= a1[i] * frcp(b1[i]); } }
            asm volatile("" ::: "memory");
        }
    }
    __device__ __forceinline__ void operator()(const f32x4 (&acc)[2][2][4][2], const Unit& u, int wr, int wc, int fr, int fq) const {
#pragma unroll
        for (int ai = 0; ai < 2; ++ai)
#pragma unroll
            for (int m = 0; m < 4; ++m) {
                const int row = u.pm * 256 + ai * 128 + wr * 64 + m * 16 + fr;
#pragma unroll
                for (int bj = 0; bj < 2; ++bj) {
                    const int c = u.pn * 256 + bj * 128 + wc * 32 + 8 * fq;
                    f32x4 g0, g1; unpack8(*(const GAS u32x4*)(Pg + (size_t)row * PW + PC_GATE + 2048 + c), g0, g1);
                    *(GAS u32x4*)(Mgp + (size_t)row * 1024 + c) = pack8(acc[ai][bj][m][0] * g0, acc[ai][bj][m][1] * g1);
                }
            }
    }
};
struct EpiOutRS {
    static constexpr bool PERM = true, HOOK = false;
    GAS bf16_t* O; LAS float* rsq;
    __device__ __forceinline__ void operator()(const f32x4 (&acc)[2][2][4][2], const Unit& u, int wr, int wc, int fr, int fq) const {
#pragma unroll
        for (int ai = 0; ai < 2; ++ai)
#pragma unroll
            for (int m = 0; m < 4; ++m) {
                const int rl = ai * 128 + wr * 64 + m * 16 + fr; const size_t row = (size_t)u.pm * 256 + rl;
                float sq = 0.f;
#pragma unroll
                for (int bj = 0; bj < 2; ++bj) {
                    const f32x4 v0 = acc[ai][bj][m][0], v1 = acc[ai][bj][m][1];
                    *(GAS u32x4*)(O + row * 1024 + u.pn * 256 + bj * 128 + wc * 32 + 8 * fq) = pack8(v0, v1);
                    sq += (v0[0] * v0[0] + v0[1] * v0[1]) + (v0[2] * v0[2] + v0[3] * v0[3]) + (v1[0] * v1[0] + v1[1] * v1[1]) + (v1[2] * v1[2] + v1[3] * v1[3]);
                }
                sq += __shfl_xor(sq, 16); sq += __shfl_xor(sq, 32);
                if (fq == 0) rsq[(u.aux * 4 + wc) * 256 + rl] = sq;
            }
    }
};
struct EpiQ {
    static constexpr bool PERM = false, HOOK = false;
    GAS bf16_t* Q; const GAS float* cosT; const GAS float* sinT;
    __device__ __forceinline__ void operator()(const f32x4 (&acc)[2][2][4][2], const Unit& u, int wr, int wc, int fr, int fq) const {
        const float sc = 0.10206207261596577f * LOG2E;
#pragma unroll
        for (int ai = 0; ai < 2; ++ai)
#pragma unroll
            for (int m = 0; m < 4; ++m) {
                const int row = u.pm * 256 + ai * 128 + wr * 64 + m * 16 + fr;
#pragma unroll
                for (int bj = 0; bj < 2; ++bj) {
                    const int c0 = u.pn * 256 + bj * 128 + wc * 32;
                    f32x4 a = acc[ai][bj][m][0] * sc, b = acc[ai][bj][m][1] * sc;
                    if ((c0 % 96) == 64) {
                        const f32x4 cs = *(const GAS f32x4*)(cosT + (size_t)row * 16 + 4 * fq), sn = *(const GAS f32x4*)(sinT + (size_t)row * 16 + 4 * fq);
                        const f32x4 ra = a * cs - b * sn, rb = b * cs + a * sn; a = ra; b = rb;
                    }
                    u32x2 w0, w1; w0.x = pk2(a[0], a[1]); w0.y = pk2(a[2], a[3]); w1.x = pk2(b[0], b[1]); w1.y = pk2(b[2], b[3]);
                    GAS bf16_t* qp = Q + (size_t)row * 768 + c0 + 4 * fq;
                    *(GAS u32x2*)qp = w0; *(GAS u32x2*)(qp + 16) = w1;
                }
            }
    }
};

template <int DQK, int DV, int RH, bool NEGM>
__device__ __forceinline__ void attn_unit(LAS unsigned char* lds, const GAS bf16_t* Q, int qpitch, const GAS bf16_t* K, int kpitch,
                                          const GAS bf16_t* Vt, int vpitch, int nkv, const GAS bf16_t* ZI, GAS bf16_t* ZO, int zpitch, const int wave_) {
    constexpr int CH = DQK / 8, KCH = 64 * CH, NKL = (KCH + 511) / 512, VCH = DV * 8, NVL = VCH / 512;
    constexpr int KROWB = (DQK + 8) * 2, KBUF = 64 * KROWB, VROWB = 136, VBUF = DV * VROWB;
    int lane_ = lane_id_(); asm volatile("" : "+v"(lane_));
    const int lane = lane_, wid = wave_, tid = wave_ * 64 + lane, r32 = lane & 31, hi = lane >> 5;
    const bool grpB = false;
    LAS unsigned char* Kl = lds; LAS unsigned char* Vl = lds + 2 * KBUF;
    bf16x8 qf[RH][DQK / 16];
#pragma unroll
    for (int hh = 0; hh < RH; ++hh) { const GAS bf16_t* qp = Q + (size_t)(wid * 32 * RH + hh * 32 + r32) * qpitch + hi * 8;
#pragma unroll
      for (int d0 = 0; d0 < DQK / 16; ++d0) qf[hh][d0] = *(const GAS bf16x8*)(qp + d0 * 16); }
    u32x4 kr[NKL], vr[NVL];
#define AT_GLOAD(t) do { \
        _Pragma("unroll") for (int i_ = 0; i_ < NKL; ++i_) { const int id_ = tid + i_ * 512; if (id_ < KCH) { const int r_ = id_ / CH, c_ = id_ % CH; kr[i_] = *(const GAS u32x4*)(K + (size_t)((t) * 64 + r_) * kpitch + c_ * 8); } } \
        _Pragma("unroll") for (int i_ = 0; i_ < NVL; ++i_) { const int id_ = tid + i_ * 512; const int r_ = id_ >> 3, c_ = id_ & 7; vr[i_] = *(const GAS u32x4*)(Vt + (size_t)r_ * vpitch + (t) * 64 + c_ * 8); } } while (0)
#define AT_LSTORE(kb_, vs_) do { \
        _Pragma("unroll") for (int i_ = 0; i_ < NKL; ++i_) { const int id_ = tid + i_ * 512; if (id_ < KCH) { const int r_ = id_ / CH, c_ = id_ % CH; *(LAS u32x4*)(Kl + (kb_) * KBUF + r_ * KROWB + c_ * 16) = kr[i_]; } } \
        _Pragma("unroll") for (int i_ = 0; i_ < NVL; ++i_) { const int id_ = tid + i_ * 512; const int r_ = id_ >> 3, c_ = id_ & 7; LAS unsigned char* p_ = Vl + (vs_) * VBUF + r_ * VROWB + c_ * 16; \
            *(LAS u32x2*)p_ = (u32x2){vr[i_].x, vr[i_].y}; *(LAS u32x2*)(p_ + 8) = (u32x2){vr[i_].z, vr[i_].w}; } } while (0)
    f32x16 o[RH][DV / 32];
#pragma unroll
    for (int hh = 0; hh < RH; ++hh)
#pragma unroll
        for (int dt = 0; dt < DV / 32; ++dt)
#pragma unroll
            for (int r = 0; r < 16; ++r) o[hh][dt][r] = 0.f;
    float mref[RH], lacc[RH][4];
#pragma unroll
    for (int hh = 0; hh < RH; ++hh) { mref[hh] = 0.f; lacc[hh][0] = lacc[hh][1] = lacc[hh][2] = lacc[hh][3] = 0.f; }
    f32x16 zero16;
#pragma unroll
    for (int r = 0; r < 16; ++r) zero16[r] = 0.f;
    f32x16 negm[RH];
    float zf_ = 0.f; asm volatile("" : "+v"(zf_));
#pragma unroll
    for (int hh = 0; hh < RH; ++hh) {
#pragma unroll
        for (int r = 0; r < 16; ++r) negm[hh][r] = zf_;
        if constexpr (NEGM) asm volatile("" : "+v"(negm[hh])); }
    bf16x8 pb[RH][4];
    bf16x8 vf[NEGM ? DV / 32 : 1][4];
    bf16x8 ka_[NEGM ? DQK / 16 : 1], kb2_[NEGM ? DQK / 16 : 1];
    bool first = true;
#define AT_KLD2(d0_) do { _Pragma("unroll") for (int dd_ = (d0_); dd_ < (d0_) + 2; ++dd_) { ka_[dd_] = *(const LAS bf16x8*)(kbp_ + dd_ * 32); kb2_[dd_] = *(const LAS bf16x8*)(kbp_ + 32 * KROWB + dd_ * 32); } } while (0)
#define AT_KMM2(d0_) do { _Pragma("unroll") for (int dd_ = (d0_); dd_ < (d0_) + 2; ++dd_) _Pragma("unroll") for (int hh = 0; hh < RH; ++hh) { \
                p[hh][0] = __builtin_amdgcn_mfma_f32_32x32x16_bf16(ka_[dd_], qf[hh][dd_], dd_ == 0 ? negm[hh] : p[hh][0], 0, 0, 0); \
                p[hh][1] = __builtin_amdgcn_mfma_f32_32x32x16_bf16(kb2_[dd_], qf[hh][dd_], dd_ == 0 ? negm[hh] : p[hh][1], 0, 0, 0); } } while (0)
#define AT_QK_LD0(kb_) do { if constexpr (NEGM) { const LAS unsigned char* kbp_ = Kl + (kb_) * KBUF + r32 * KROWB + hi * 16; AT_KLD2(0); __builtin_amdgcn_sched_barrier(0); } } while (0)
#define AT_QK(kb_) do { \
        const LAS unsigned char* kbp_ = Kl + (kb_) * KBUF + r32 * KROWB + hi * 16; \
        if constexpr (NEGM) {            \
            AT_KLD2(2); AT_KMM2(0); __builtin_amdgcn_sched_barrier(0); \
            AT_KLD2(4); AT_KMM2(2); __builtin_amdgcn_sched_barrier(0); \
            AT_KMM2(4); \
        } else { \
        _Pragma("unroll") for (int d0 = 0; d0 < DQK / 16; ++d0) { \
            const bf16x8 a0 = *(const LAS bf16x8*)(kbp_ + d0 * 32), a1 = *(const LAS bf16x8*)(kbp_ + 32 * KROWB + d0 * 32); \
            _Pragma("unroll") for (int hh = 0; hh < RH; ++hh) { \
                p[hh][0] = __builtin_amdgcn_mfma_f32_32x32x16_bf16(a0, qf[hh][d0], d0 == 0 ? zero16 : p[hh][0], 0, 0, 0); \
                p[hh][1] = __builtin_amdgcn_mfma_f32_32x32x16_bf16(a1, qf[hh][d0], d0 == 0 ? zero16 : p[hh][1], 0, 0, 0); } } } } while (0)
#define AT_SOFTMAX() do { \
        _Pragma("unroll") for (int hh = 0; hh < RH; ++hh) { \
            if constexpr (!NEGM) { const float mr_ = mref[hh]; _Pragma("unroll") for (int r = 0; r < 16; ++r) { p[hh][0][r] -= mr_; p[hh][1][r] -= mr_; } } \
            float mxa = __builtin_fmaxf(p[hh][0][0], p[hh][1][0]), mxb = __builtin_fmaxf(p[hh][0][1], p[hh][1][1]), mxc = __builtin_fmaxf(p[hh][0][2], p[hh][1][2]), mxd = __builtin_fmaxf(p[hh][0][3], p[hh][1][3]); \
            _Pragma("unroll") for (int r = 4; r < 16; r += 4) { mxa = __builtin_fmaxf(__builtin_fmaxf(mxa, p[hh][0][r]), p[hh][1][r]); mxb = __builtin_fmaxf(__builtin_fmaxf(mxb, p[hh][0][r + 1]), p[hh][1][r + 1]); \
                mxc = __builtin_fmaxf(__builtin_fmaxf(mxc, p[hh][0][r + 2]), p[hh][1][r + 2]); mxd = __builtin_fmaxf(__builtin_fmaxf(mxd, p[hh][0][r + 3]), p[hh][1][r + 3]); } \
            float mx = __builtin_fmaxf(__builtin_fmaxf(mxa, mxb), __builtin_fmaxf(mxc, mxd)); \
            { auto rr_ = __builtin_amdgcn_permlane32_swap(__float_as_uint(mx), __float_as_uint(mx), false, false); mx = __builtin_fmaxf(__uint_as_float(rr_[0]), __uint_as_float(rr_[1])); } \
            if (first || __any(mx > 8.f)) {              \
                const float dl = first ? mx : __builtin_fmaxf(mx, 0.f), alpha = fexp2(-dl); \
                mref[hh] += dl; lacc[hh][0] *= alpha; lacc[hh][1] *= alpha; lacc[hh][2] *= alpha; lacc[hh][3] *= alpha; \
                if constexpr (NEGM) { _Pragma("unroll") for (int r = 0; r < 16; ++r) negm[hh][r] = -mref[hh]; asm volatile("" : "+v"(negm[hh])); } \
                _Pragma("unroll") for (int r = 0; r < 16; ++r) { p[hh][0][r] -= dl; p[hh][1][r] -= dl; } \
                _Pragma("unroll") for (int dt = 0; dt < DV / 32; ++dt) _Pragma("unroll") for (int r = 0; r < 16; ++r) o[hh][dt][r] *= alpha; \
            } \
            _Pragma("unroll") for (int r = 0; r < 16; ++r) { p[hh][0][r] = fexp2(p[hh][0][r]); p[hh][1][r] = fexp2(p[hh][1][r]); } \
            _Pragma("unroll") for (int r = 0; r < 16; r += 4) { lacc[hh][0] += p[hh][0][r] + p[hh][1][r]; lacc[hh][1] += p[hh][0][r + 1] + p[hh][1][r + 1]; lacc[hh][2] += p[hh][0][r + 2] + p[hh][1][r + 2]; lacc[hh][3] += p[hh][0][r + 3] + p[hh][1][r + 3]; } \
            u32x4 w; \
            w.x = pk2(p[hh][0][0], p[hh][0][1]); w.y = pk2(p[hh][0][2], p[hh][0][3]); w.z = pk2(p[hh][0][4], p[hh][0][5]); w.w = pk2(p[hh][0][6], p[hh][0][7]); pb[hh][0] = __builtin_bit_cast(bf16x8, w); \
            w.x = pk2(p[hh][0][8], p[hh][0][9]); w.y = pk2(p[hh][0][10], p[hh][0][11]); w.z = pk2(p[hh][0][12], p[hh][0][13]); w.w = pk2(p[hh][0][14], p[hh][0][15]); pb[hh][1] = __builtin_bit_cast(bf16x8, w); \
            w.x = pk2(p[hh][1][0], p[hh][1][1]); w.y = pk2(p[hh][1][2], p[hh][1][3]); w.z = pk2(p[hh][1][4], p[hh][1][5]); w.w = pk2(p[hh][1][6], p[hh][1][7]); pb[hh][2] = __builtin_bit_cast(bf16x8, w); \
            w.x = pk2(p[hh][1][8], p[hh][1][9]); w.y = pk2(p[hh][1][10], p[hh][1][11]); w.z = pk2(p[hh][1][12], p[hh][1][13]); w.w = pk2(p[hh][1][14], p[hh][1][15]); pb[hh][3] = __builtin_bit_cast(bf16x8, w); \
        } first = false; } while (0)
#define AT_VLOAD(vs_) do { if constexpr (NEGM) { \
        _Pragma("unroll") for (int dt = 0; dt < DV / 32; ++dt) { \
            const LAS unsigned char* vb_ = Vl + (vs_) * VBUF + (dt * 32 + r32) * VROWB + hi * 8; \
            _Pragma("unroll") for (int ks = 0; ks < 4; ++ks) { \
                const u32x2 lo_ = *(const LAS u32x2*)(vb_ + ks * 32), hh2_ = *(const LAS u32x2*)(vb_ + ks * 32 + 16); \
                const u32x4 aw_ = {lo_.x, lo_.y, hh2_.x, hh2_.y}; vf[dt][ks] = __builtin_bit_cast(bf16x8, aw_); } } \
        __builtin_amdgcn_sched_barrier(0); } } while (0)
#define AT_PV(vs_) do { if constexpr (NEGM) { \
        _Pragma("unroll") for (int ks = 0; ks < 4; ++ks) _Pragma("unroll") for (int dt = 0; dt < DV / 32; ++dt) \
            _Pragma("unroll") for (int hh = 0; hh < RH; ++hh) o[hh][dt] = __builtin_amdgcn_mfma_f32_32x32x16_bf16(vf[dt][ks], pb[hh][ks], o[hh][dt], 0, 0, 0); \
        } else { \
        _Pragma("unroll") for (int dt = 0; dt < DV / 32; ++dt) { \
            const LAS unsigned char* vb_ = Vl + (vs_) * VBUF + (dt * 32 + r32) * VROWB + hi * 8; \
            _Pragma("unroll") for (int ks = 0; ks < 4; ++ks) { \
                const u32x2 lo_ = *(const LAS u32x2*)(vb_ + ks * 32), hh2_ = *(const LAS u32x2*)(vb_ + ks * 32 + 16); \
                const u32x4 aw_ = {lo_.x, lo_.y, hh2_.x, hh2_.y}; \
                _Pragma("unroll") for (int hh = 0; hh < RH; ++hh) o[hh][dt] = __builtin_amdgcn_mfma_f32_32x32x16_bf16(__builtin_bit_cast(bf16x8, aw_), pb[hh][ks], o[hh][dt], 0, 0, 0); } } } } while (0)
    const int NT = nkv / 64;
    AT_GLOAD(0); AT_LSTORE(0, 0); __syncthreads();
    int vs_prev = 2, vs_cur = 0, vs_next = 1;
    if (!grpB) {
        for (int t = 0; t < NT; ++t) {
            const int kb = t & 1;
            if (t + 1 < NT) AT_GLOAD(t + 1);
            f32x16 p[RH][2];
            AT_QK_LD0(kb); AT_QK(kb); AT_VLOAD(vs_cur); AT_SOFTMAX(); AT_PV(vs_cur);
            if (t + 1 < NT) AT_LSTORE(kb ^ 1, vs_next);
            __syncthreads();
            vs_prev = vs_cur; vs_cur = vs_next; vs_next = (vs_next == 2) ? 0 : vs_next + 1;
        }
    } else {
        f32x16 p[RH][2];
        { if (1 < NT) AT_GLOAD(1); AT_QK_LD0(0); AT_QK(0); if (1 < NT) AT_LSTORE(1, 1); __syncthreads(); vs_prev = 0; vs_cur = 1; vs_next = 2; }
        for (int t = 1; t < NT; ++t) {
            const int kb = t & 1;
            if (t + 1 < NT) AT_GLOAD(t + 1);
            AT_VLOAD(vs_prev); AT_SOFTMAX(); AT_QK_LD0(kb); AT_PV(vs_prev); AT_QK(kb);
            if (t + 1 < NT) AT_LSTORE(kb ^ 1, vs_next);
            __syncthreads();
            vs_prev = vs_cur; vs_cur = vs_next; vs_next = (vs_next == 2) ? 0 : vs_next + 1;
        }
        AT_VLOAD(vs_prev); AT_SOFTMAX(); AT_PV(vs_prev);
    }
#undef AT_GLOAD
#undef AT_LSTORE
#undef AT_QK
#undef AT_QK_LD0
#undef AT_KLD2
#undef AT_KMM2
#undef AT_SOFTMAX
#undef AT_PV
#undef AT_VLOAD
#pragma unroll
    for (int hh = 0; hh < RH; ++hh) {
        float l = (lacc[hh][0] + lacc[hh][1]) + (lacc[hh][2] + lacc[hh][3]); l += __shfl_xor(l, 32);
        const float inv = 1.f / l;
        const size_t ro = (size_t)(wid * 32 * RH + hh * 32 + r32) * zpitch;
#pragma unroll
        for (int dt = 0; dt < DV / 32; ++dt)
#pragma unroll
            for (int i = 0; i < 4; ++i) {
                const int c = dt * 32 + 8 * i + 4 * hi;
                const u32x2 zw = *(const GAS u32x2*)(ZI + ro + c);
                u32x2 w;
                w.x = pk2(o[hh][dt][4 * i + 0] * inv * bf_lo(zw.x), o[hh][dt][4 * i + 1] * inv * bf_hi(zw.x));
                w.y = pk2(o[hh][dt][4 * i + 2] * inv * bf_lo(zw.y), o[hh][dt][4 * i + 3] * inv * bf_hi(zw.y));
                *(GAS u32x2*)(ZO + ro + c) = w;
            }
    }
    __syncthreads();
}

__device__ __forceinline__ void transpose_item(const GAS float* W, int N, int k0, int n0, GAS bf16_t* WT, int ldt, int drow0, LAS float* scr, int lane) {
    float tv[32];
#pragma unroll
    for (int i = 0; i < 32; ++i) { const int kk = 2 * i + (lane >> 5); tv[i] = __builtin_nontemporal_load(W + (size_t)(k0 + kk) * N + n0 + (lane & 31)); }
#pragma unroll
    for (int i = 0; i < 32; ++i) { const int kk = 2 * i + (lane >> 5); scr[kk * 33 + (lane & 31)] = tv[i]; }
    asm volatile("s_waitcnt lgkmcnt(0)" ::: "memory");
    const int c = lane & 7;
#pragma unroll
    for (int j = 0; j < 4; ++j) { const int n = (lane >> 3) + 8 * j; const LAS float* s = scr + (8 * c) * 33 + n;
        u32x4 o; o.x = pk2(s[0 * 33], s[1 * 33]); o.y = pk2(s[2 * 33], s[3 * 33]); o.z = pk2(s[4 * 33], s[5 * 33]); o.w = pk2(s[6 * 33], s[7 * 33]);
        *(GAS u32x4*)(WT + (size_t)(drow0 + n) * ldt + k0 + 8 * c) = o; }
    asm volatile("s_waitcnt lgkmcnt(0)" ::: "memory");
}
__device__ __forceinline__ int win_row(int n0) {
    if (n0 < 1024) return n0;
    if (n0 < 1440) return n0 - 1024 + 5632;
    if (n0 < 1952) return n0 - 1440 + 1024;
    if (n0 < 2464) return n0 - 1952 + 2048;
    if (n0 < 2976) return n0 - 2464 + 1536;
    return n0 - 2976 + 2560;
}
__device__ __forceinline__ void rms_row_1024(const GAS float* xrow, const GAS float* g, GAS bf16_t* orow, int lane) {
    const GAS f32x4* xr = (const GAS f32x4*)xrow + lane; const GAS f32x4* gr = (const GAS f32x4*)g + lane;
    f32x4 v[4]; float s = 0.f;
#pragma unroll
    for (int j = 0; j < 4; ++j) { v[j] = xr[64 * j]; s += (v[j].x * v[j].x + v[j].y * v[j].y) + (v[j].z * v[j].z + v[j].w * v[j].w); }
    const float rstd = 1.f / sqrtf(wave_sum(s) * (1.f / 1024.f) + NORM_EPS);
    GAS u32x2* o8 = (GAS u32x2*)orow + lane;
#pragma unroll
    for (int j = 0; j < 4; ++j) { const f32x4 gg = gr[64 * j]; u32x2 w; w.x = pk2(v[j].x * rstd * gg.x, v[j].y * rstd * gg.y); w.y = pk2(v[j].z * rstd * gg.z, v[j].w * rstd * gg.w); o8[64 * j] = w; }
}

__device__ __forceinline__ void rms_row2_1024(const GAS float* x0, const GAS float* x1, const GAS float* g, GAS bf16_t* o0, GAS bf16_t* o1, int lane) {
    const GAS f32x4* xr0 = (const GAS f32x4*)x0 + lane; const GAS f32x4* xr1 = (const GAS f32x4*)x1 + lane; const GAS f32x4* gr = (const GAS f32x4*)g + lane;
    f32x4 v[4], w[4]; float s = 0.f, s2 = 0.f;
#pragma unroll
    for (int j = 0; j < 4; ++j) { v[j] = __builtin_nontemporal_load(xr0 + 64 * j); w[j] = __builtin_nontemporal_load(xr1 + 64 * j); }
#pragma unroll
    for (int j = 0; j < 4; ++j) { s += (v[j].x * v[j].x + v[j].y * v[j].y) + (v[j].z * v[j].z + v[j].w * v[j].w); s2 += (w[j].x * w[j].x + w[j].y * w[j].y) + (w[j].z * w[j].z + w[j].w * w[j].w); }
#pragma unroll
    for (int o = 1; o < 64; o <<= 1) { s += __shfl_xor(s, o); s2 += __shfl_xor(s2, o); }
    const float r0 = 1.f / sqrtf(s * (1.f / 1024.f) + NORM_EPS), r1 = 1.f / sqrtf(s2 * (1.f / 1024.f) + NORM_EPS);
    GAS u32x2* p0 = (GAS u32x2*)o0 + lane; GAS u32x2* p1 = (GAS u32x2*)o1 + lane;
#pragma unroll
    for (int j = 0; j < 4; ++j) { const f32x4 gg = gr[64 * j]; u32x2 a, b;
        a.x = pk2(v[j].x * r0 * gg.x, v[j].y * r0 * gg.y); a.y = pk2(v[j].z * r0 * gg.z, v[j].w * r0 * gg.w);
        b.x = pk2(w[j].x * r1 * gg.x, w[j].y * r1 * gg.y); b.y = pk2(w[j].z * r1 * gg.z, w[j].w * r1 * gg.w);
        p0[64 * j] = a; p1[64 * j] = b; }
}


#define XB_TMO      128
#define XB_XCNT(j)  (256  + 64 * (j))
#define XB_XSUB(j)  (1280 + 64 * (j))
#define XB_XGEN(j)  (2304 + 64 * (j))
#define XB_TOP      3328
#define XB_TOPGEN   3392
#define XCD_BAR_WORDS 3456
#define XB_SPIN_CAP (1u << 18)
__device__ __forceinline__ unsigned xb_ld(unsigned* p)              { return __hip_atomic_load(p, __ATOMIC_RELAXED, __HIP_MEMORY_SCOPE_AGENT); }
__device__ __forceinline__ unsigned xb_add(unsigned* p, unsigned v) { return __hip_atomic_fetch_add(p, v, __ATOMIC_RELAXED, __HIP_MEMORY_SCOPE_AGENT); }
__device__ __forceinline__ unsigned xb_xcc_id() { return (unsigned)__builtin_amdgcn_s_getreg((3 << 11) | 20) & 0xFu; }
#define XB_SPIN(cond, bar) do { unsigned _sp = 0; while (cond) { __builtin_amdgcn_s_sleep(1); \
    if ((++_sp & 255u) == 0u) { if (xb_ld(&(bar)[XB_TMO])) break; if (_sp > XB_SPIN_CAP) { atomicAdd(&(bar)[XB_TMO], 1u); break; } } } } while (0)
struct XcdBarrier { unsigned* bar; unsigned x; volatile LAS unsigned* st; };
__device__ __forceinline__ XcdBarrier xcd_barrier_post(unsigned* bar, volatile LAS unsigned* st) {
    XcdBarrier b; b.bar = bar; b.x = xb_xcc_id(); b.st = st;
    if (threadIdx.x == 0) (void)xb_add(&bar[XB_XCNT(b.x)], 1u);
    return b;
}
__device__ __forceinline__ void xcd_barrier_complete(unsigned* bar, unsigned x, unsigned& nloc, unsigned& nx) {
    const unsigned G = gridDim.x * gridDim.y * gridDim.z;
    unsigned sum, cnt, mine, sp = 0u;
    for (;;) {
        sum = 0u; cnt = 0u; mine = 0u;
#pragma unroll
        for (unsigned j = 0; j < 16; ++j) { const unsigned c = xb_ld(&bar[XB_XCNT(j)]); sum += c; cnt += (c > 0u) ? 1u : 0u; mine = (j == x) ? c : mine; }
        if (sum == G) break;
        __builtin_amdgcn_s_sleep(1);
        if ((++sp & 255u) == 0u) { if (xb_ld(&bar[XB_TMO])) break; if (sp > XB_SPIN_CAP) { atomicAdd(&bar[XB_TMO], 1u); break; } }
    }
    nloc = mine > 0u ? mine : 1u; nx = cnt > 0u ? cnt : 1u;
}
__device__ __forceinline__ void xcd_barrier(const XcdBarrier& b, const int wave_) {
    asm volatile("s_waitcnt vmcnt(0)" ::: "memory");
    __syncthreads();
    if (wave_ == 0 && lane_id_() == 0) {
        unsigned* bar = b.bar;
        __builtin_amdgcn_s_waitcnt(0);
        unsigned nloc = b.st[0], nx = b.st[1];
        if (nloc == 0u) { xcd_barrier_complete(bar, b.x, nloc, nx); b.st[0] = nloc; b.st[1] = nx; }
        const unsigned old = xb_add(&bar[XB_XSUB(b.x)], 1u);
        const unsigned gen = old / nloc;
        if (old + 1u == (gen + 1u) * nloc) {
            __builtin_amdgcn_fence(__ATOMIC_RELEASE, "agent");
            asm volatile("s_waitcnt vmcnt(0)" ::: "memory");
            const unsigned og = xb_add(&bar[XB_TOP], 1u);
            const unsigned tg = og / nx;
            if (og + 1u == (tg + 1u) * nx) xb_add(&bar[XB_TOPGEN], 1u);
            else XB_SPIN(xb_ld(&bar[XB_TOPGEN]) == tg, bar);
            __builtin_amdgcn_fence(__ATOMIC_ACQUIRE, "agent");
            xb_add(&bar[XB_XGEN(b.x)], 1u);
            asm volatile("s_waitcnt vmcnt(0)" ::: "memory");
        } else {
            XB_SPIN(xb_ld(&bar[XB_XGEN(b.x)]) == gen, bar);
            __builtin_amdgcn_fence(__ATOMIC_ACQUIRE, "agent");
            asm volatile("s_waitcnt vmcnt(0)" ::: "memory");
        }
    }
    __syncthreads();
}

struct Args {
    const float* in[27]; float* out; unsigned char* ws; int pad0, pad1;
};
enum { I_X = 0, I_MEM, I_POS, I_PRENORM, I_WIN, I_BGATE, I_LRE, I_LIM, I_LOGDT, I_BRE, I_BIM, I_CRE, I_CIM, I_SSMD, I_GLUW, I_GLUB,
       I_QNORM, I_WQUP, I_KVNORM, I_WKVUP, I_MEMNORM, I_MEMWKV, I_WBSSM, I_WBMLA, I_WBMEM, I_WOUT, I_POSTNORM };

#ifndef PHASE_MASK
#define PHASE_MASK 0xFFFFF
#endif
#define PH(n) if constexpr ((PHASE_MASK >> (n)) & 1)
constexpr int LDS_BYTES = 147456;


__device__ __forceinline__ GAS unsigned char* launder(unsigned char* p) { asm volatile("" : "+s"(p)); return (GAS unsigned char*)p; }
__device__ __forceinline__ int opq(int v) { asm volatile("" : "+s"(v)); return v; }
#define PHASE_BASES GAS unsigned char* WSB = launder(a.ws); GAS unsigned char* DOB = launder((unsigned char*)a.out); int lane_ = lane_id_(); asm volatile("" : "+v"(lane_)); const int lane = lane_, tid = wave * 64 + lane, gtid = bx * 512 + tid; (void)lane; (void)gtid; (void)DOB; (void)WSB
#define Win_t ((GAS bf16_t*)(WSB + WS_WIN))
#define Wglu_t ((GAS bf16_t*)(WSB + WS_WGLU))
#define Wq_t ((GAS bf16_t*)(WSB + WS_WQ))
#define Wk_t ((GAS bf16_t*)(WSB + WS_WK))
#define Wv_t ((GAS bf16_t*)(WSB + WS_WV))
#define Wmk_t ((GAS bf16_t*)(WSB + WS_WMK))
#define Wmv_t ((GAS bf16_t*)(WSB + WS_WMV))
#define Wbr_t ((GAS bf16_t*)(WSB + WS_WBR))
#define Wout_t ((GAS bf16_t*)(WSB + WS_WOUT))
#define ME_t ((GAS bf16_t*)(WSB + WS_MET))
#define MY_t ((GAS bf16_t*)(WSB + WS_MYT))
#define cosT ((GAS float*)(WSB + WS_COS))
#define sinT ((GAS float*)(WSB + WS_SIN))
#define apow ((GAS float*)(WSB + WS_APOW))
#define Bbar ((GAS float*)(WSB + WS_BBAR))
#define Kt ((GAS float*)(WSB + WS_KT))
#define Kmem ((GAS bf16_t*)(WSB + WS_KMEM))
#define Vtmem ((GAS bf16_t*)(WSB + WS_VTMEM))
#define P ((GAS bf16_t*)(WSB + WS_P))
#define CQR ((GAS bf16_t*)(WSB + WS_CQR))
#define Vt ((GAS bf16_t*)(WSB + WS_VT))
#define Ap ((GAS bf16_t*)(WSB + WS_AP))
#define OUTB ((GAS bf16_t*)(WSB + WS_OUT))
#define CQN ((GAS bf16_t*)(WSB + WS_CQN))
#define CKVN ((GAS bf16_t*)(WSB + WS_CKVN))
#define H ((GAS bf16_t*)(DOB + DO_H))
#define MEMN ((GAS bf16_t*)(WSB + WS_Y))
#define Eb ((GAS bf16_t*)(DOB + DO_E))
#define Kbuf ((GAS bf16_t*)(DOB + DO_KBUF))
#define Qb ((GAS bf16_t*)(DOB + DO_QB))
#define Yb ((GAS bf16_t*)(WSB + WS_Y))
#define Mg ((GAS bf16_t*)(WSB + WS_MG))

__global__ void __launch_bounds__(512, 2) fwd_mega(Args a) {
    extern __shared__ __attribute__((aligned(16))) unsigned char lds_raw[];
    LAS unsigned char* lds = (LAS unsigned char*)lds_raw;
    cg::grid_group grid = cg::this_grid();
    volatile LAS unsigned* bar_st = (volatile LAS unsigned*)(lds + 131072 + 64);
    if (threadIdx.x < 2) bar_st[threadIdx.x] = 0u;
    __syncthreads();
    const XcdBarrier xbar = xcd_barrier_post((unsigned*)(a.ws + WS_CTL), bar_st);
    if (a.pad0 != 0) grid.sync();
    const int wave = __builtin_amdgcn_readfirstlane(threadIdx.x >> 6);
    const int G = gridDim.x, bx = blockIdx.x;
    const int vcu = (G % 8 == 0) ? (bx % 8) * (G / 8) + bx / 8 : bx;
    const int gw = vcu * 8 + wave, NGW = G * 8;
    const int NTH = G * 512;
    PH(0) {
        PHASE_BASES;
        LAS float* scr = (LAS float*)(lds + wave * 16384);
        constexpr int I0 = 16 * 189, I1 = 8 * 16, I2 = 4 * 24, I3 = 2 * 32, I4 = 16 * 32, I5 = 3 * 8 * 32, I6 = 16 * 32;
        constexpr int NIT = I0 + I1 + I2 + I3 + I4 + I5 + I6;
        for (int it = gw; it < NIT; it += NGW) {
            int r = it;
            if (r < I0) { const int kb = r / 189, nb = r % 189; transpose_item(((const GAS float*)a.in[opq(I_WIN)]), 6048, kb * 64, nb * 32, Win_t, 1024, win_row(nb * 32), scr, lane); continue; } r -= I0;
            if (r < I1) { const int kb = r / 16, nb = r % 16; transpose_item(((const GAS float*)a.in[opq(I_GLUW)]), 512, kb * 64, nb * 32, Wglu_t, 512, nb * 32, scr, lane); continue; } r -= I1;
            if (r < I2) { const int kb = r / 24, nb = r % 24; transpose_item(((const GAS float*)a.in[opq(I_WQUP)]), 768, kb * 64, nb * 32, Wq_t, 256, nb * 32, scr, lane); continue; } r -= I2;
            if (r < I3) { const int kb = r / 32, nb = r % 32, n0 = nb * 32, h = n0 >> 7, w = n0 & 127;
                if (w < 64) transpose_item(((const GAS float*)a.in[opq(I_WKVUP)]), 1024, kb * 64, n0, Wk_t, 128, h * 64 + w, scr, lane);
                else transpose_item(((const GAS float*)a.in[opq(I_WKVUP)]), 1024, kb * 64, n0, Wv_t, 128, h * 64 + w - 64, scr, lane);
                continue; } r -= I3;
            if (r < I4) { const int kb = r / 32, nb = r % 32, n0 = nb * 32;
                if (n0 < 512) transpose_item(((const GAS float*)a.in[opq(I_MEMWKV)]), 1024, kb * 64, n0, Wmk_t, 1024, n0, scr, lane);
                else transpose_item(((const GAS float*)a.in[opq(I_MEMWKV)]), 1024, kb * 64, n0, Wmv_t, 1024, n0 - 512, scr, lane);
                continue; } r -= I4;
            if (r < I5) { const int seg = r / 256, rr = r % 256, kb = rr / 32, nb = rr % 32;
                const GAS float* W = seg == 0 ? ((const GAS float*)a.in[opq(I_WBSSM)]) : (seg == 1 ? ((const GAS float*)a.in[opq(I_WBMLA)]) : ((const GAS float*)a.in[opq(I_WBMEM)]));
                transpose_item(W, 1024, kb * 64, nb * 32, Wbr_t + (size_t)seg * 512, 1536, nb * 32, scr, lane); continue; } r -= I5;
            { const int kb = r / 32, nb = r % 32; transpose_item(((const GAS float*)a.in[opq(I_WOUT)]), 1024, kb * 64, nb * 32, Wout_t, 1024, nb * 32, scr, lane); }
        }
        for (int i = gtid; i < 96 * 1024 / 8; i += NTH) *(GAS u32x4*)(Win_t + (size_t)6048 * 1024 + (size_t)i * 8) = (u32x4){0u, 0u, 0u, 0u};
        { const GAS float* xin = ((const GAS float*)a.in[opq(I_X)]); const GAS float* gin = ((const GAS float*)a.in[opq(I_PRENORM)]);
          for (int m = gw; m < TOK; m += 2 * NGW) rms_row2_1024(xin + (size_t)m * 1024, xin + (size_t)(m + NGW) * 1024, gin, H + (size_t)m * 1024, H + (size_t)(m + NGW) * 1024, lane); }
        for (int m = gw; m < 2048; m += NGW) rms_row_1024(((const GAS float*)a.in[opq(I_MEM)]) + (size_t)m * 1024, ((const GAS float*)a.in[opq(I_MEMNORM)]), MEMN + (size_t)m * 1024, lane);
        { const GAS int* pos = (const GAS int*)a.in[opq(I_POS)];
          for (int i = gtid; i < TOK * 16; i += NTH) { const int t = i >> 4, j = i & 15;
              const float invf = powf(10000.f, -(float)(2 * j) / 32.f);
              float s, c; sincos_red((double)pos[t] * (double)invf, s, c); cosT[i] = c; sinT[i] = s; } }
        for (int dg = NGW - 1 - gw; dg < 64; dg += NGW) {
            const float dt = expf(((const GAS float*)a.in[opq(I_LOGDT)])[dg]);
            const float lr = ((const GAS float*)a.in[opq(I_LRE)])[dg * 64 + lane], li = ((const GAS float*)a.in[opq(I_LIM)])[dg * 64 + lane];
            float a_re = 0.f, a_im = 0.f;
            for (int e = 0; e <= 16; ++e) {
                const float mag = expf(lr * dt * (float)e); float s, c; sincos_red((double)li * (double)dt * (double)e, s, c);
                apow[((size_t)(dg * 17 + e) * 64 + lane) * 2 + 0] = mag * c; apow[((size_t)(dg * 17 + e) * 64 + lane) * 2 + 1] = mag * s;
                if (e == 1) { a_re = mag * c; a_im = mag * s; }
            }
            const float den = lr * lr + li * li, f_re = a_re - 1.f;
            const float z_re = (f_re * lr + a_im * li) / den, z_im = (a_im * lr - f_re * li) / den;
            const GAS float* bre_ = ((const GAS float*)a.in[opq(I_BRE)]); const GAS float* bim_ = ((const GAS float*)a.in[opq(I_BIM)]);
#pragma unroll
            for (int p = 0; p < 16; ++p) {
                const float br = bre_[((size_t)dg * 64 + lane) * 16 + p], bi = bim_[((size_t)dg * 64 + lane) * 16 + p];
                Bbar[(((size_t)dg * 64 + lane) * 16 + p) * 2 + 0] = z_re * br - z_im * bi;
                Bbar[(((size_t)dg * 64 + lane) * 16 + p) * 2 + 1] = z_re * bi + z_im * br;
            }
        }
    }
    xcd_barrier(xbar, wave);

    {
      PHASE_BASES;
      PH(1) {
        const GAS float* c_re = ((const GAS float*)a.in[opq(I_CRE)]); const GAS float* c_im = ((const GAS float*)a.in[opq(I_CIM)]);
        for (int idx = gtid; idx < 64 * 16 * 256; idx += NTH) {
            const int pp = idx & 255, tau = (idx >> 8) & 15, dg = idx >> 12, p = pp >> 4, p2 = pp & 15;
            float acc = 0.f;
#pragma unroll 8
            for (int n = 0; n < 64; ++n) {
                const float wr_ = apow[((size_t)(dg * 17 + tau) * 64 + n) * 2], wi_ = apow[((size_t)(dg * 17 + tau) * 64 + n) * 2 + 1];
                const float br = Bbar[(((size_t)dg * 64 + n) * 16 + p2) * 2], bi = Bbar[(((size_t)dg * 64 + n) * 16 + p2) * 2 + 1];
                const float xr = wr_ * br - wi_ * bi, xi = wr_ * bi + wi_ * br;
                acc += c_re[((size_t)dg * 16 + p) * 64 + n] * xr - c_im[((size_t)dg * 16 + p) * 64 + n] * xi;
            }
            Kt[idx] = acc;
        }
        for (int idx = gtid; idx < 32 * 256 * 32; idx += NTH) {
            const int k8 = idx & 31, o = (idx >> 5) & 255, g = idx >> 13, j = k8 >> 1, p0 = (k8 & 1) * 8;
            const int dir = o >> 7, ri = (o >> 6) & 1, n = o & 63, dg = dir * 32 + g, e = dir ? j : 15 - j;
            const float wr_ = apow[((size_t)(dg * 17 + e) * 64 + n) * 2], wi_ = apow[((size_t)(dg * 17 + e) * 64 + n) * 2 + 1];
            float v[8];
#pragma unroll
            for (int q = 0; q < 8; ++q) { const float br = Bbar[(((size_t)dg * 64 + n) * 16 + p0 + q) * 2], bi = Bbar[(((size_t)dg * 64 + n) * 16 + p0 + q) * 2 + 1];
                v[q] = ri ? (wr_ * bi + wi_ * br) : (wr_ * br - wi_ * bi); }
            u32x4 w; w.x = pk2(v[0], v[1]); w.y = pk2(v[2], v[3]); w.z = pk2(v[4], v[5]); w.w = pk2(v[6], v[7]);
            *(GAS u32x4*)(ME_t + ((size_t)(g * 256 + o) * 256 + k8 * 8)) = w;
        }
        for (int idx = gtid; idx < 32 * 256 * 32; idx += NTH) {
            const int c8 = idx & 31, o = (idx >> 5) & 255, g = idx >> 13, j = o >> 4, p = o & 15;
            const int dir = c8 >> 4, ri = (c8 >> 3) & 1, n0 = (c8 & 7) * 8, dg = dir * 32 + g, e = dir ? 16 - j : j + 1;
            float v[8];
#pragma unroll
            for (int q = 0; q < 8; ++q) { const int n = n0 + q;
                const float wr_ = apow[((size_t)(dg * 17 + e) * 64 + n) * 2], wi_ = apow[((size_t)(dg * 17 + e) * 64 + n) * 2 + 1];
                const float cr = c_re[((size_t)dg * 16 + p) * 64 + n], ci = c_im[((size_t)dg * 16 + p) * 64 + n];
                v[q] = ri ? -(cr * wi_ + ci * wr_) : (cr * wr_ - ci * wi_); }
            u32x4 w; w.x = pk2(v[0], v[1]); w.y = pk2(v[2], v[3]); w.z = pk2(v[4], v[5]); w.w = pk2(v[6], v[7]);
            *(GAS u32x4*)(MY_t + ((size_t)(g * 256 + o) * 512 + 256 + c8 * 8)) = w;
        }
      }
        __syncthreads();
        PH(2) {
            pg8::Gemm g{H, Win_t, 1024, 1024, 1024}; pg8::SchedPlain S{TOK / 256, NPROJ / 256, G, bx, (size_t)256 * 1024 * 2, (size_t)256 * 1024 * 2};
            pg8::Epi8<FProj> E{FProj{Ap, P, CQR, ((const GAS float*)a.in[opq(I_BGATE)])}};
            pg8::gemm_phase(lds, g, S, E, wave);
        }
    }
    xcd_barrier(xbar, wave);

    {
      PHASE_BASES;
      PH(5) {
        const GAS float* qn = ((const GAS float*)a.in[opq(I_QNORM)]); const GAS float* kvn = ((const GAS float*)a.in[opq(I_KVNORM)]);
        const bool memwg = (G > 32) && (bx < 32);
        if (memwg) {
        PH(3) {
            pg8::Gemm g{MEMN, Wmk_t, 1024, 1024, 1024}; pg8::SchedPlain S{8, 2, G, bx, (size_t)256 * 1024 * 2, (size_t)256 * 1024 * 2};
            pg8::Epi8<FStore> E{FStore{Kmem, 512}};
            pg8::gemm_phase(lds, g, S, E, wave);
        }
        PH(4) {
            pg8::Gemm g{Wmv_t, MEMN, 1024, 1024, 1024}; pg8::SchedPlain S{2, 8, G, (bx + G - 16) % G, (size_t)256 * 1024 * 2, (size_t)256 * 1024 * 2};
            pg8::Epi8<FVtMem> E{FVtMem{Vtmem}};
            pg8::gemm_phase(lds, g, S, E, wave);
        }
        } else {
        const int gwr = ((G > 32) ? bx - 32 : bx) * 8 + wave, NGWR = ((G > 32) ? G - 32 : G) * 8;
        for (int t0 = gwr; t0 < TOK; t0 += 2 * NGWR) {
            const bool v1_ = t0 + NGWR < TOK;
            u32x2 wq[2]; unsigned wk[2]; float xs[2][4], xo[2][4], cs[2][4], sn[2][4];
            const int h = lane >> 3, d0 = (lane & 7) * 4;
#pragma unroll
            for (int rr = 0; rr < 2; ++rr) { const size_t t = (size_t)t0 + ((rr && v1_) ? (size_t)NGWR : 0); const GAS bf16_t* src = CQR + t * 512;
                wq[rr] = *(const GAS u32x2*)(src + lane * 4); wk[rr] = *(const GAS unsigned*)(src + 256 + lane * 2);
#pragma unroll
                for (int i = 0; i < 4; ++i) { const int d = d0 + i, dd = d & 15; xs[rr][i] = bf2f(src[384 + d]); xo[rr][i] = bf2f(src[384 + (d ^ 16)]);
                    cs[rr][i] = cosT[t * 16 + dd]; sn[rr][i] = sinT[t * 16 + dd]; } }
            const f32x4 gq = *(const GAS f32x4*)(qn + lane * 4); const float gk0 = kvn[lane * 2], gk1 = kvn[lane * 2 + 1];
            float x[2][4], y[2][2], sq[2], sk[2];
#pragma unroll
            for (int rr = 0; rr < 2; ++rr) { x[rr][0] = bf_lo(wq[rr].x); x[rr][1] = bf_hi(wq[rr].x); x[rr][2] = bf_lo(wq[rr].y); x[rr][3] = bf_hi(wq[rr].y);
                y[rr][0] = bf_lo(wk[rr]); y[rr][1] = bf_hi(wk[rr]);
                sq[rr] = x[rr][0] * x[rr][0] + x[rr][1] * x[rr][1] + x[rr][2] * x[rr][2] + x[rr][3] * x[rr][3]; sk[rr] = y[rr][0] * y[rr][0] + y[rr][1] * y[rr][1]; }
#pragma unroll
            for (int o = 1; o < 64; o <<= 1) { sq[0] += __shfl_xor(sq[0], o); sq[1] += __shfl_xor(sq[1], o); sk[0] += __shfl_xor(sk[0], o); sk[1] += __shfl_xor(sk[1], o); }
#pragma unroll
            for (int rr = 0; rr < 2; ++rr) { if (rr && !v1_) continue; const size_t t = (size_t)t0 + (size_t)rr * NGWR;
                const float rq = 1.f / sqrtf(sq[rr] * (1.f / 256.f) + NORM_EPS), rk = 1.f / sqrtf(sk[rr] * (1.f / 128.f) + NORM_EPS);
                u32x2 o; o.x = pk2(x[rr][0] * rq * gq.x, x[rr][1] * rq * gq.y); o.y = pk2(x[rr][2] * rq * gq.z, x[rr][3] * rq * gq.w);
                *(GAS u32x2*)(CQN + t * 256 + lane * 4) = o;
                *(GAS unsigned*)(CKVN + t * 128 + lane * 2) = pk2(y[rr][0] * rk * gk0, y[rr][1] * rk * gk1);
                float ov[4];
#pragma unroll
                for (int i = 0; i < 4; ++i) ov[i] = (d0 + i < 16) ? (xs[rr][i] * cs[rr][i] - xo[rr][i] * sn[rr][i]) : (xs[rr][i] * cs[rr][i] + xo[rr][i] * sn[rr][i]);
                u32x2 ok; ok.x = pk2(ov[0], ov[1]); ok.y = pk2(ov[2], ov[3]);
                *(GAS u32x2*)(Kbuf + t * 768 + h * 96 + 64 + d0) = ok; }
        }
        }
        { const GAS float* dsk = ((const GAS float*)a.in[opq(I_SSMD)]);
          for (int idx = gtid; idx < 32 * 256 * 32; idx += NTH) {
              const int k8 = idx & 31, o = (idx >> 5) & 255, g = idx >> 13, j = o >> 4, p = o & 15, j2 = k8 >> 1, q0 = (k8 & 1) * 8;
              float v[8];
#pragma unroll
              for (int q = 0; q < 8; ++q) { const int p2 = q0 + q; float x = 0.f;
                  if (j2 <= j) x += Kt[((size_t)(g * 16 + (j - j2))) * 256 + p * 16 + p2];
                  if (j2 >= j) x += Kt[((size_t)((32 + g) * 16 + (j2 - j))) * 256 + p * 16 + p2];
                  if (j2 == j && p2 == p) x += dsk[g * 16 + p];
                  v[q] = x; }
              u32x4 w; w.x = pk2(v[0], v[1]); w.y = pk2(v[2], v[3]); w.z = pk2(v[4], v[5]); w.w = pk2(v[6], v[7]);
              *(GAS u32x4*)(MY_t + ((size_t)(g * 256 + o) * 512 + k8 * 8)) = w;
          } }
      }
        PH(6) {
            pg8::Gemm g{Ap, ME_t, 512, 256, 256}; pg8::SchedBatch8 S{256, G, bx, (size_t)256 * 512 * 2, (size_t)256 * 256 * 2};
            pg8::Epi8<FStore> E{FStore{Eb, 256}};
            pg8::gemm_phase(lds, g, S, E, wave);
        }
    }
    xcd_barrier(xbar, wave);

    {
        PHASE_BASES;
        LAS float* tot = (LAS float*)lds;
        PH(7) for (int it2 = 2 * bx; it2 < 32 * 8 * 2; it2 += 2 * G) for (int it = it2; it < it2 + 2; ++it) {
            const int dir = it & 1, b = (it >> 1) & 7, g = it >> 4, dg = dir * 32 + g;
            const float aq_r = apow[((size_t)(dg * 17 + 16) * 64 + lane) * 2], aq_i = apow[((size_t)(dg * 17 + 16) * 64 + lane) * 2 + 1];
            float er[32], ei[32];
            const size_t rowbase = (size_t)g * 2048 + b * 256;
            const int c0 = dir ? 255 - wave * 32 : wave * 32; const long estr = dir ? -256 : 256, sstr = dir ? -512 : 512;
            const GAS bf16_t* ep0 = Eb + (rowbase + c0) * 256 + dir * 128 + lane;
            GAS bf16_t* sp0 = Ap + (rowbase + c0) * 512 + 256 + dir * 128 + lane;
#pragma unroll
            for (int k = 0; k < 32; ++k) { const GAS bf16_t* ep = ep0 + (long)k * estr; er[k] = bf2f(ep[0]); ei[k] = bf2f(ep[64]); }
            float sr = 0.f, si = 0.f;
#pragma unroll
            for (int k = 0; k < 32; ++k) { const float nr = aq_r * sr - aq_i * si + er[k], ni = aq_r * si + aq_i * sr + ei[k]; sr = nr; si = ni; }
            tot[(wave * 64 + lane) * 2] = sr; tot[(wave * 64 + lane) * 2 + 1] = si;
            float pr = aq_r, pi = aq_i;
#pragma unroll
            for (int s = 0; s < 5; ++s) { const float nr = pr * pr - pi * pi, ni = 2.f * pr * pi; pr = nr; pi = ni; }
            __syncthreads();
            sr = 0.f; si = 0.f;
            for (int w = 0; w < wave; ++w) { const float tr = tot[(w * 64 + lane) * 2], ti = tot[(w * 64 + lane) * 2 + 1];
                const float nr = pr * sr - pi * si + tr, ni = pr * si + pi * sr + ti; sr = nr; si = ni; }
#pragma unroll
            for (int k = 0; k < 32; ++k) { GAS bf16_t* sp = sp0 + (long)k * sstr;
                sp[0] = (bf16_t)(pk2(sr, 0.f) & 0xffffu); sp[64] = (bf16_t)(pk2(si, 0.f) & 0xffffu);
                const float nr = aq_r * sr - aq_i * si + er[k], ni = aq_r * si + aq_i * sr + ei[k]; sr = nr; si = ni; }
            __syncthreads();
        }
        asm volatile("s_waitcnt vmcnt(0)" ::: "memory"); __syncthreads();
        PH(13) {
            pg8::Gemm g{Ap, MY_t, 512, 512, 512}; pg8::SchedBatch8 S{256, G, bx, (size_t)256 * 512 * 2, (size_t)256 * 512 * 2};
            pg8::Epi8<FSsmY> E{FSsmY{Yb}};
            pg8::gemm_phase(lds, g, S, E, wave);
        }
        PH(8) {
            pg8::Gemm g{CQN, Wq_t, 256, 256, 256}; pg8::SchedPlain S{TOK / 256, 3, G, bx, (size_t)256 * 256 * 2, (size_t)256 * 256 * 2};
            EpiQ E{Qb, cosT, sinT};
            pg8::gemm_phase(lds, g, S, E, wave);
        }
        PH(9) {
            pg8::Gemm g{CKVN, Wk_t, 128, 128, 128}; pg8::SchedPlain S{TOK / 256, 2, G, bx, (size_t)256 * 128 * 2, (size_t)256 * 128 * 2};
            pg8::Epi8<FKnope> E{FKnope{Kbuf}};
            pg8::gemm_phase(lds, g, S, E, wave);
        }
        PH(10) {
            pg8::Gemm g{Wv_t, CKVN, 128, 128, 128}; pg8::SchedPlain S{2, TOK / 256, G, bx, (size_t)256 * 128 * 2, (size_t)256 * 128 * 2};
            pg8::Epi8<FVt> E{FVt{Vt}};
            pg8::gemm_phase(lds, g, S, E, wave);
        }
    }
    xcd_barrier(xbar, wave);

    {
        PHASE_BASES;
        if (wave >= 4) __builtin_amdgcn_s_setprio(1);
        PH(11) for (int L = vcu; L < 8 * 8 * 16; L += G) {
            const int qb = L & 15, bh = L >> 4, b = bh >> 3, h = bh & 7; const size_t row0 = (size_t)b * SEQ + qb * 256;
            attn_unit<96, 64, 1, true>(lds, Qb + row0 * 768 + h * 96, 768, Kbuf + (size_t)b * SEQ * 768 + h * 96, 768,
                              Vt + (size_t)(b * 512 + h * 64) * 4096, 4096, SEQ, P + row0 * PW + PC_ZMLA + h * 64, P + row0 * PW + PC_ZMLA + h * 64, PW, wave);
        }
        PH(12) for (int L = vcu; L < 8 * 4 * 16; L += G) {
            const int qb = L & 15, bh = L >> 4, b = bh >> 2, h = bh & 3; const size_t row0 = (size_t)b * SEQ + qb * 256;
            attn_unit<128, 128, 1, false>(lds, P + row0 * PW + PC_QMEM + h * 128, PW, Kmem + (size_t)b * 256 * 512 + h * 128, 512,
                                Vtmem + (size_t)(b * 512 + h * 128) * 256, 256, 256, P + row0 * PW + PC_ZMEM + h * 128, P + row0 * PW + PC_ZMEM + h * 128, PW, wave);
        }
        __builtin_amdgcn_s_setprio(0);
        PH(14) {
            pg8::Gemm g{Yb, Wglu_t, 512, 512, 512}; pg8::SchedPlain S{TOK / 256, 2, G, bx, (size_t)256 * 512 * 2, (size_t)256 * 512 * 2};
            pg8::Epi8<FGlu> E{FGlu{Yb, P, ((const GAS float*)a.in[opq(I_GLUB)])}};
            pg8::gemm_phase(lds, g, S, E, wave);
        }
    }
    xcd_barrier(xbar, wave);

    PH(15) {
        PHASE_BASES;
        pg8::Gemm g{P, Wbr_t, PW, 1536, 1536};
        if (G == 256) {
            pg8::SchedPair S{bx, (size_t)256 * PW * 2, (size_t)256 * 1536 * 2};
            EpiBranchH E{P, Mg};
            pg8::gemm_phase(lds, g, S, E, wave);
        } else {
        pg8::SchedPlain S{TOK / 256, 4, G, bx, (size_t)256 * PW * 2, (size_t)256 * 1536 * 2};
        EpiBranchH E{P, Mg};
        pg8::gemm_phase(lds, g, S, E, wave);
        }
    }
    xcd_barrier(xbar, wave);

    if (G == 256) {
        PHASE_BASES;
        LAS float* rsq = (LAS float*)(lds + 131072 + 1024);
        LAS float* tot = rsq + 8 * 256;
        {
            pg8::Gemm g{Mg, Wout_t, 1024, 1024, 1024}; pg8::SchedPair S{bx, (size_t)256 * 1024 * 2, (size_t)256 * 1024 * 2};
            EpiOutRS E{OUTB, rsq};
            pg8::gemm_phase(lds, g, S, E, wave);
        }
        asm volatile("s_waitcnt vmcnt(0) lgkmcnt(0)" ::: "memory"); __syncthreads();
        float* xch = (float*)(a.ws + WS_CTL + 65536);
        unsigned* flg = (unsigned*)(a.ws + WS_CTL) + 3520;
        if (tid < 256) { float sv = 0.f;
#pragma unroll
            for (int k = 0; k < 8; ++k) sv += rsq[k * 256 + tid];
            tot[tid] = sv; __hip_atomic_store(xch + bx * 256 + tid, sv, __ATOMIC_RELAXED, __HIP_MEMORY_SCOPE_AGENT); }
        asm volatile("s_waitcnt vmcnt(0) lgkmcnt(0)" ::: "memory"); __syncthreads();
        if (tid == 0) {
            __hip_atomic_store(flg + bx, 1u, __ATOMIC_RELAXED, __HIP_MEMORY_SCOPE_AGENT);
            unsigned sp = 0u; while (__hip_atomic_load(flg + (bx ^ 1), __ATOMIC_RELAXED, __HIP_MEMORY_SCOPE_AGENT) == 0u) { __builtin_amdgcn_s_sleep(1); if (++sp > (1u << 22)) break; }
            __builtin_amdgcn_fence(__ATOMIC_ACQUIRE, "agent");
        }
        __syncthreads();
        if (tid < 256) { const float spv = __hip_atomic_load(xch + (bx ^ 1) * 256 + tid, __ATOMIC_RELAXED, __HIP_MEMORY_SCOPE_AGENT);
            tot[tid] = 1.f / sqrtf((tot[tid] + spv) * (1.f / 1024.f) + NORM_EPS); }
        __syncthreads();
        {
            const GAS float* x = ((const GAS float*)a.in[opq(I_X)]); const GAS float* pn = ((const GAS float*)a.in[opq(I_POSTNORM)]);
            const int cb = (bx & 1) * 512 + lane * 8; const size_t row0 = (size_t)(bx >> 1) * 256 + wave * 32;
            const f32x4 g0 = *(const GAS f32x4*)(pn + cb), g1 = *(const GAS f32x4*)(pn + cb + 4);
            for (int rr = 0; rr < 32; rr += 4) {
                u32x4 ow[4]; f32x4 x0[4], x1[4];
#pragma unroll
                for (int k = 0; k < 4; ++k) { const size_t off = (row0 + rr + k) * 1024 + cb; ow[k] = *(const GAS u32x4*)(OUTB + off);
                    x0[k] = __builtin_nontemporal_load((const GAS f32x4*)(x + off)); x1[k] = __builtin_nontemporal_load((const GAS f32x4*)(x + off + 4)); }
#pragma unroll
                for (int k = 0; k < 4; ++k) { const size_t off = (row0 + rr + k) * 1024 + cb; const float rstd = tot[wave * 32 + rr + k];
                    f32x4 lo, hi; unpack8(ow[k], lo, hi);
                    __builtin_nontemporal_store(x0[k] + lo * rstd * g0, (GAS f32x4*)(((GAS float*)a.out) + off));
                    __builtin_nontemporal_store(x1[k] + hi * rstd * g1, (GAS f32x4*)(((GAS float*)a.out) + off + 4)); }
            }
        }
    } else {
    PH(16) {
        PHASE_BASES;
        pg8::Gemm g{Mg, Wout_t, 1024, 1024, 1024}; pg8::SchedPlain S{TOK / 256, 4, G, bx, (size_t)256 * 1024 * 2, (size_t)256 * 1024 * 2};
        pg8::Epi8<FStore> E{FStore{OUTB, 1024}};
        pg8::gemm_phase(lds, g, S, E, wave);
    }
    xcd_barrier(xbar, wave);
    PH(17) {
        PHASE_BASES;
        const GAS float* x = ((const GAS float*)a.in[opq(I_X)]); const GAS float* pn = ((const GAS float*)a.in[opq(I_POSTNORM)]);
        for (int m0 = gw; m0 < TOK; m0 += 2 * NGW) {
            u32x4 ow[2][2]; f32x4 xv[2][4];
#pragma unroll
            for (int rr = 0; rr < 2; ++rr) { const size_t m = (size_t)m0 + (size_t)rr * NGW;
#pragma unroll
                for (int j = 0; j < 2; ++j) { ow[rr][j] = *(const GAS u32x4*)(OUTB + m * 1024 + j * 512 + lane * 8);
                    xv[rr][2 * j] = __builtin_nontemporal_load((const GAS f32x4*)(x + m * 1024 + j * 512 + lane * 8)); xv[rr][2 * j + 1] = __builtin_nontemporal_load((const GAS f32x4*)(x + m * 1024 + j * 512 + lane * 8 + 4)); } }
            f32x4 v[2][4]; float s[2];
#pragma unroll
            for (int rr = 0; rr < 2; ++rr) { s[rr] = 0.f;
#pragma unroll
                for (int j = 0; j < 2; ++j) { f32x4 lo, hi; unpack8(ow[rr][j], lo, hi); v[rr][2 * j] = lo; v[rr][2 * j + 1] = hi;
                    s[rr] += (lo.x * lo.x + lo.y * lo.y) + (lo.z * lo.z + lo.w * lo.w) + (hi.x * hi.x + hi.y * hi.y) + (hi.z * hi.z + hi.w * hi.w); } }
#pragma unroll
            for (int o = 1; o < 64; o <<= 1) { s[0] += __shfl_xor(s[0], o); s[1] += __shfl_xor(s[1], o); }
#pragma unroll
            for (int rr = 0; rr < 2; ++rr) { const size_t m = (size_t)m0 + (size_t)rr * NGW; const float rstd = 1.f / sqrtf(s[rr] * (1.f / 1024.f) + NORM_EPS);
#pragma unroll
                for (int q = 0; q < 4; ++q) { const int c = (q >> 1) * 512 + lane * 8 + (q & 1) * 4; const f32x4 gv = *(const GAS f32x4*)(pn + c);
                    __builtin_nontemporal_store(xv[rr][q] + v[rr][q] * rstd * gv, (GAS f32x4*)(((GAS float*)a.out) + m * 1024 + c)); } }
        }
    }
    }
}

extern "C" void kernel_launch(void* const* d_in, const int* in_sizes, int n_in, void* d_out, int out_size, void* d_ws, size_t ws_size, hipStream_t stream) {
    static int grid = 0;
    if (grid == 0) {
        if (n_in != 27 || out_size != TOK * DM || ws_size < WS_END) { fprintf(stderr, "kernel_launch: unexpected problem shape (n_in %d, out %d, ws %zu)\n", n_in, out_size, ws_size); grid = -1; return; }
        int dev = 0, cus = 0, per_cu = 0;
        hipGetDevice(&dev); hipDeviceGetAttribute(&cus, hipDeviceAttributeMultiprocessorCount, dev);
        if (hipFuncSetAttribute((const void*)fwd_mega, hipFuncAttributeMaxDynamicSharedMemorySize, LDS_BYTES) != hipSuccess) { fprintf(stderr, "hipFuncSetAttribute failed\n"); grid = -1; return; }
        if (hipOccupancyMaxActiveBlocksPerMultiprocessor(&per_cu, (const void*)fwd_mega, 512, LDS_BYTES) != hipSuccess || per_cu < 1) { fprintf(stderr, "occupancy query: %d\n", per_cu); per_cu = 1; }
        (void)hipGetLastError();
        grid = cus * 1;
    }
    if (grid < 0) return;
    if (hipMemsetAsync((char*)d_ws + WS_CTL, 0, CTL_BYTES, stream) != hipSuccess) { fprintf(stderr, "memset of barrier words failed\n"); return; }
    Args a{};
    for (int i = 0; i < 27; ++i) a.in[i] = (const float*)d_in[i];
    a.out = (float*)d_out; a.ws = (unsigned char*)d_ws;
    void* args[] = {&a};
    hipError_t e = hipLaunchCooperativeKernel((const void*)fwd_mega, dim3(grid), dim3(512), args, LDS_BYTES, stream);
    if (e != hipSuccess) fprintf(stderr, "cooperative launch failed: %s (grid %d)\n", hipGetErrorString(e), grid);
}
```

```cpp
#include <hip/hip_runtime.h>
#include <hip/hip_cooperative_groups.h>
#include <cstdio>
#include <cstdint>
namespace cg = cooperative_groups;

#define LAS __attribute__((address_space(3)))
#define GAS __attribute__((address_space(1)))
typedef unsigned short bf16_t;
typedef short bf16x8 __attribute__((ext_vector_type(8)));
typedef float f32x4 __attribute__((ext_vector_type(4)));
typedef float f32x16 __attribute__((ext_vector_type(16)));
typedef unsigned u32x4 __attribute__((ext_vector_type(4)));
typedef unsigned u32x2 __attribute__((ext_vector_type(2)));

constexpr int TOK = 32768, DM = 1024, SEQ = 4096, NB = 8;
constexpr int NPROJ = 6144;
constexpr int PW = 5120;
constexpr int PC_ZSSM = 0, PC_ZMLA = 512, PC_ZMEM = 1024, PC_QMEM = 1536, PC_GATE = 2048;
constexpr float LOG2E = 1.4426950408889634f;
constexpr float NORM_EPS = 1e-6f;

constexpr size_t MiB = 1u << 20;
constexpr size_t WS_WIN = 0;
constexpr size_t WS_WGLU = 12 * MiB;
constexpr size_t WS_WQ = WS_WGLU + 512 * 1024;
constexpr size_t WS_WK = WS_WQ + 384 * 1024;
constexpr size_t WS_WV = WS_WK + 128 * 1024;
constexpr size_t WS_WMK = 14 * MiB;
constexpr size_t WS_WMV = 15 * MiB;
constexpr size_t WS_WBR = 16 * MiB;
constexpr size_t WS_WOUT = 19 * MiB;
constexpr size_t WS_MET = 21 * MiB;
constexpr size_t WS_MYT = 25 * MiB;
constexpr size_t WS_COS = 33 * MiB;
constexpr size_t WS_SIN = 35 * MiB;
constexpr size_t WS_APOW = 37 * MiB;
constexpr size_t WS_BBAR = 38 * MiB;
constexpr size_t WS_KT = 39 * MiB;
constexpr size_t WS_KMEM = 40 * MiB;
constexpr size_t WS_VTMEM = 42 * MiB;
constexpr size_t WS_CTL = 44 * MiB, CTL_BYTES = 16384;
constexpr size_t WS_P = 48 * MiB;
constexpr size_t WS_CQR = 368 * MiB;
constexpr size_t WS_VT = WS_CQR;
constexpr size_t WS_AP = 400 * MiB;
constexpr size_t WS_OUT = WS_P;
constexpr size_t WS_MG = 368 * MiB;
constexpr size_t WS_CQN = 464 * MiB;
constexpr size_t WS_CKVN = 0;
constexpr size_t WS_Y = 480 * MiB;
constexpr size_t WS_END = 512 * MiB;
constexpr size_t DO_H = 0;
constexpr size_t DO_MEMN = 64 * MiB;
constexpr size_t DO_E = 0;
constexpr size_t DO_KBUF = 32 * MiB;
constexpr size_t DO_QB = 80 * MiB;
constexpr size_t DO_Y = 0;
constexpr size_t DO_MERGED = 0;

__device__ __forceinline__ unsigned pk2(float lo, float hi) {
    typedef float f2 __attribute__((ext_vector_type(2))); typedef __bf16 b2 __attribute__((ext_vector_type(2)));
    f2 v = {lo, hi}; b2 b = __builtin_convertvector(v, b2); return __builtin_bit_cast(unsigned, b);
}
__device__ __forceinline__ float bf_lo(unsigned w) { return __uint_as_float(w << 16); }
__device__ __forceinline__ float bf_hi(unsigned w) { return __uint_as_float(w & 0xffff0000u); }
__device__ __forceinline__ float bf2f(bf16_t h) { return __uint_as_float((unsigned)h << 16); }
__device__ __forceinline__ float fexp2(float x) { return __builtin_amdgcn_exp2f(x); }
__device__ __forceinline__ float frcp(float x) { return __builtin_amdgcn_rcpf(x); }
__device__ __forceinline__ float sigmoidf_(float x) { return frcp(1.f + fexp2(-x * LOG2E)); }
__device__ __forceinline__ float siluf_(float x) { return x * sigmoidf_(x); }
__device__ __forceinline__ float gelu_tanh(float x) { const float u = 0.7978845608028654f * (x + 0.044715f * x * x * x); return x * sigmoidf_(2.f * u); }
__device__ __forceinline__ int lane_id_() { return (int)__builtin_amdgcn_mbcnt_hi(~0u, __builtin_amdgcn_mbcnt_lo(~0u, 0u)); }
__device__ __forceinline__ float wave_sum(float v) {
#pragma unroll
    for (int o = 1; o < 64; o <<= 1) v += __shfl_xor(v, o);
    return v;
}
__device__ __forceinline__ void sincos_red(double ang, float& s, float& c) {
    const double k = rint(ang * 0.15915494309189535);
    const float r = (float)(ang - k * 6.283185307179586);
    s = sinf(r); c = cosf(r);
}

namespace pg8 {
constexpr int BM = 256, BK = 64, HALF = 128, HTB = HALF * BK * 2, STAGE_BYTES = 8 * HTB, NXCD = 8, WGM = 8;
__host__ __device__ __forceinline__ int lds_byte(int r, int c) { const int st = (r >> 4) * 2 + (c >> 5), rr = r & 15, cc = c & 31, ob = rr * 64 + cc * 2; return st * 1024 + (ob ^ (((ob >> 9) & 1) << 5)); }
__host__ __device__ __forceinline__ void stage_rc(int b, int& R, int& C) { const int st = b / 1024, sb = b % 1024, swz = sb ^ (((sb >> 9) & 1) << 5); R = (st >> 1) * 16 + swz / 64; C = (st & 1) * 32 + (swz % 64) / 2; }
__host__ __device__ __forceinline__ int perm32(int rho) { const int n = rho >> 4, i = rho & 15; return 8 * (i >> 2) + 4 * n + (i & 3); }

struct Unit { int pm, pn, aux, pad_; size_t aoff, boff; };
struct Gemm { const GAS bf16_t* A; const GAS bf16_t* Bt; int lda, ldb, K; };

__device__ __forceinline__ bool tile_order(long L, int nM, int nN, int& pm, int& pn) {
    const int nwg = nM * nN; if (L >= nwg) return false;
    int wgid = (int)L; { const int q = nwg / NXCD, r = nwg % NXCD, xcd = wgid % NXCD, off = wgid / NXCD; wgid = (xcd < r ? xcd * (q + 1) : r * (q + 1) + (xcd - r) * q) + off; }
    const int nig = WGM * nN, gid = wgid / nig, fm = gid * WGM, gsz = (nM - fm) < WGM ? (nM - fm) : WGM;
    pm = fm + ((wgid % nig) % gsz); pn = (wgid % nig) / gsz; return true;
}
struct SchedPlain {
    int nM, nN, G, c; size_t astep, bstep;
    __device__ __forceinline__ bool next(int i, Unit& u) const {
        if (!tile_order((long)i * G + c, nM, nN, u.pm, u.pn)) return false;
        u.aux = 0; u.pad_ = 0; u.aoff = (size_t)u.pm * astep; u.boff = (size_t)u.pn * bstep; return true; }
};
struct SchedBatch8 {
    int nM, G, c; size_t astep, bstep;
    __device__ __forceinline__ bool next(int i, Unit& u) const {
        const long L = (long)i * G + c; if (L >= nM) return false;
        u.pm = (int)L; u.pn = 0; u.aux = 0; u.pad_ = 0; u.aoff = (size_t)u.pm * astep; u.boff = (size_t)(u.pm >> 3) * bstep; return true; }
};
struct SchedPair {
    int c; size_t astep, bstep;
    __device__ __forceinline__ bool next(int i, Unit& u) const {
        if (i >= 2) return false;
        u.pm = c >> 1; u.pn = 2 * (c & 1) + i; u.aux = i; u.pad_ = 0; u.aoff = (size_t)u.pm * astep; u.boff = (size_t)u.pn * bstep; return true; }
};
struct SchedBranch {
    int nM, nN, G, c; size_t astep, bstep;
    __device__ __forceinline__ bool next(int i, Unit& u) const {
        const int seg = i % 3, it = i / 3;
        if (!tile_order((long)it * G + c, nM, nN, u.pm, u.pn)) return false;
        u.aux = seg; u.pad_ = 0; u.aoff = (size_t)u.pm * astep + (size_t)(seg == 0 ? PC_ZSSM * 2 : (seg == 1 ? PC_ZMLA * 2 : PC_ZMEM * 2)); u.boff = (size_t)(seg * nN + u.pn) * bstep; return true; }
};

template <class Epi, class Sched>
__device__ __forceinline__ void gemm_phase(LAS unsigned char* lds, const Gemm g, const Sched& S, const Epi& E, const int wave_) {
    int lane_ = lane_id_(); asm volatile("" : "+v"(lane_));
    const int lane = lane_, wid = wave_, tid = wave_ * 64 + lane, wr = wid >> 2, wc = wid & 3, fr = lane & 15, fq = lane >> 4;
    int K_ = g.K; asm volatile("" : "+s"(K_));
    const int K = K_, nt = K / BK;
    unsigned voffA[2], voffB[2];
#pragma unroll
    for (int i = 0; i < 2; ++i) { int R, C; stage_rc(tid * 16 + i * 8192, R, C); const int Rb = Epi::PERM ? ((R & ~31) + perm32(R & 31)) : R;
        voffA[i] = (unsigned)(R * g.lda + C) * 2u; voffB[i] = (unsigned)(Rb * g.ldb + C) * 2u; }
    const size_t kstep = (size_t)(BK * 2);
    const size_t hstepA = (size_t)HALF * g.lda * 2, hstepB = (size_t)HALF * g.ldb * 2;
    const unsigned ldsw = (unsigned)wid * 1024u;
    const int aoff = lds_byte(wr * 64 + fr, fq * 8), boff = lds_byte(wc * 32 + fr, fq * 8);
#define PG8_SA(b, h) (((b) * 2 + (h)) * HTB)
#define PG8_SB(b, h) ((4 + (b) * 2 + (h)) * HTB)
#define PG8_STAGE(bufoff, gbase, voff) do { _Pragma("unroll") for (int _i = 0; _i < 2; ++_i) \
        __builtin_amdgcn_global_load_lds((const GAS unsigned*)((const char*)(gbase) + (voff)[_i]), (LAS unsigned*)(lds + (bufoff) + ldsw + _i * 8192), 16, 0, 0); } while (0)
#define PG8_LDA(dst, b, h) do { _Pragma("unroll") for (int m = 0; m < 4; ++m) _Pragma("unroll") for (int k = 0; k < 2; ++k) dst[m][k] = *(const LAS bf16x8*)(lds + PG8_SA(b, h) + aoff + m * 2048 + k * 1024); } while (0)
#define PG8_LDB(dst, b, h) do { _Pragma("unroll") for (int n = 0; n < 2; ++n) _Pragma("unroll") for (int k = 0; k < 2; ++k) dst[n][k] = *(const LAS bf16x8*)(lds + PG8_SB(b, h) + boff + n * 2048 + k * 1024); } while (0)
#define PG8_MMA(ai, bj, At, Bt) do { __builtin_amdgcn_s_setprio(1); _Pragma("unroll") for (int m = 0; m < 4; ++m) _Pragma("unroll") for (int n = 0; n < 2; ++n) _Pragma("unroll") for (int k = 0; k < 2; ++k) \
        acc[ai][bj][m][n] = __builtin_amdgcn_mfma_f32_16x16x32_bf16(Bt[n][k], At[m][k], acc[ai][bj][m][n], 0, 0, 0); __builtin_amdgcn_s_setprio(0); } while (0)
#define PG8_WAIT_V(n) asm volatile("s_waitcnt vmcnt(" #n ")" ::: "memory")
#define PG8_WAIT_L(n) asm volatile("s_waitcnt lgkmcnt(" #n ")" ::: "memory")
#define PG8_BAR __builtin_amdgcn_s_barrier()
#define PG8_SCHED __builtin_amdgcn_sched_barrier(0)
    Unit cur, nxt; int ui = 0;
    if (!S.next(0, cur)) return;
    f32x4 acc[2][2][4][2];
#pragma unroll
    for (int a = 0; a < 2; ++a)
#pragma unroll
        for (int b = 0; b < 2; ++b)
#pragma unroll
            for (int m = 0; m < 4; ++m)
#pragma unroll
                for (int n = 0; n < 2; ++n) acc[a][b][m][n] = (f32x4){0.f, 0.f, 0.f, 0.f};
    bf16x8 At[4][2], B0[2][2], B1[2][2];
    const char* cA = (const char*)g.A + cur.aoff; const char* cB = (const char*)g.Bt + cur.boff;
    {
        PG8_STAGE(PG8_SB(0, 0), cB, voffB); PG8_STAGE(PG8_SB(0, 1), cB + hstepB, voffB); PG8_STAGE(PG8_SA(0, 0), cA, voffA); PG8_STAGE(PG8_SA(0, 1), cA + hstepA, voffA);
        if (wr == 1) PG8_BAR;
        PG8_WAIT_V(2); PG8_BAR;
        PG8_STAGE(PG8_SB(1, 0), cB + kstep, voffB); PG8_STAGE(PG8_SA(1, 0), cA + kstep, voffA); PG8_STAGE(PG8_SB(1, 1), cB + hstepB + kstep, voffB);
        PG8_WAIT_V(6); PG8_BAR;
    }
    for (;;) {
        const bool has_next = S.next(ui + 1, nxt);
        const char* nA = has_next ? (const char*)g.A + nxt.aoff : cA; const char* nB = has_next ? (const char*)g.Bt + nxt.boff : cB;
#pragma unroll 1
        for (int t = 0; t < nt; t += 2) {
            if constexpr (Epi::HOOK) { if (t == 8 || t == 16) { E.hook(acc, cur, t >> 3, wr, wc, fr, fq); PG8_WAIT_V(0); } }
            const bool last = (t == nt - 2);
            const char* a1 = cA + (size_t)(t + 1) * kstep;
            const char* a2 = last ? nA : cA + (size_t)(t + 2) * kstep; const char* b2 = last ? nB : cB + (size_t)(t + 2) * kstep;
            const char* a3 = a2 + kstep; const char* b3 = b2 + kstep;
            PG8_LDB(B0, 0, 0); PG8_LDB(B1, 0, 1); PG8_SCHED; PG8_LDA(At, 0, 0); PG8_STAGE(PG8_SA(1, 1), a1 + hstepA, voffA);
            PG8_WAIT_V(8); PG8_WAIT_L(0); PG8_BAR; PG8_MMA(0, 0, At, B0); PG8_MMA(0, 1, At, B1); PG8_BAR; PG8_SCHED;
            PG8_LDA(At, 0, 1); PG8_STAGE(PG8_SB(0, 0), b2, voffB); PG8_STAGE(PG8_SB(0, 1), b2 + hstepB, voffB); PG8_STAGE(PG8_SA(0, 0), a2, voffA);
            PG8_WAIT_V(8); PG8_WAIT_L(0); PG8_BAR; PG8_MMA(1, 0, At, B0); PG8_MMA(1, 1, At, B1); PG8_BAR; PG8_SCHED;
            PG8_LDB(B0, 1, 0); PG8_LDB(B1, 1, 1); PG8_SCHED; PG8_LDA(At, 1, 0); PG8_STAGE(PG8_SA(0, 1), a2 + hstepA, voffA);
            PG8_WAIT_V(8); PG8_WAIT_L(0); PG8_BAR; PG8_MMA(0, 0, At, B0); PG8_MMA(0, 1, At, B1); PG8_BAR; PG8_SCHED;
            PG8_LDA(At, 1, 1); PG8_STAGE(PG8_SB(1, 0), b3, voffB); PG8_STAGE(PG8_SB(1, 1), b3 + hstepB, voffB); PG8_STAGE(PG8_SA(1, 0), a3, voffA);
            PG8_WAIT_V(8); PG8_WAIT_L(0); PG8_BAR; PG8_MMA(1, 0, At, B0); PG8_MMA(1, 1, At, B1); PG8_BAR; PG8_SCHED;
        }
        if (wr == 0) PG8_BAR;
        E(acc, cur, wr, wc, fr, fq);
        if (!has_next) break;
#pragma unroll
        for (int a = 0; a < 2; ++a)
#pragma unroll
            for (int b = 0; b < 2; ++b)
#pragma unroll
                for (int m = 0; m < 4; ++m)
#pragma unroll
                    for (int n = 0; n < 2; ++n) acc[a][b][m][n] = (f32x4){0.f, 0.f, 0.f, 0.f};
        cur = nxt; cA = nA; cB = nB; ++ui;
        if (wr == 1) PG8_BAR;
    }
    PG8_WAIT_V(0);
    PG8_BAR;
#undef PG8_SA
#undef PG8_SB
#undef PG8_STAGE
#undef PG8_LDA
#undef PG8_LDB
#undef PG8_MMA
#undef PG8_WAIT_V
#undef PG8_WAIT_L
#undef PG8_BAR
#undef PG8_SCHED
}

template <class F> struct Epi8 {
    static constexpr bool PERM = true, HOOK = false;
    F f;
    __device__ __forceinline__ void operator()(const f32x4 (&acc)[2][2][4][2], const Unit& u, int wr, int wc, int fr, int fq) const {
#pragma unroll
        for (int ai = 0; ai < 2; ++ai)
#pragma unroll
            for (int m = 0; m < 4; ++m) {
                const int row = u.pm * BM + ai * HALF + wr * 64 + m * 16 + fr;
#pragma unroll
                for (int bj = 0; bj < 2; ++bj) f(u, row, bj * HALF + wc * 32 + 8 * fq, acc[ai][bj][m][0], acc[ai][bj][m][1]);
            }
    }
};
}
using pg8::Unit;

__device__ __forceinline__ u32x4 pack8(f32x4 a, f32x4 b) { u32x4 w; w.x = pk2(a[0], a[1]); w.y = pk2(a[2], a[3]); w.z = pk2(b[0], b[1]); w.w = pk2(b[2], b[3]); return w; }
__device__ __forceinline__ void unpack8(u32x4 w, f32x4& a, f32x4& b) { a = (f32x4){bf_lo(w.x), bf_hi(w.x), bf_lo(w.y), bf_hi(w.y)}; b = (f32x4){bf_lo(w.z), bf_hi(w.z), bf_lo(w.w), bf_hi(w.w)}; }

struct FProj {
    GAS bf16_t* Ap; GAS bf16_t* P; GAS bf16_t* CQR; const GAS float* b_gate;
    __device__ __forceinline__ void operator()(const Unit& u, int row, int col, f32x4 v0, f32x4 v1) const {
        const int pn = u.pn;
        if (pn < 2) {
            const int c = pn * 256 + col, g = c >> 4, p = c & 15;
            *(GAS u32x4*)(Ap + ((size_t)(g * 2048 + (row >> 4)) * 512 + (row & 15) * 16 + p)) = pack8(v0, v1);
        } else if (pn < 22) {
            const int pc = pn * 256 - 512 + col;
            if (pn >= 10) {
                const f32x4 b0 = *(const GAS f32x4*)(b_gate + pc - PC_GATE), b1 = *(const GAS f32x4*)(b_gate + pc - PC_GATE + 4);
#pragma unroll
                for (int i = 0; i < 4; ++i) { v0[i] = sigmoidf_(v0[i] + b0[i]); v1[i] = sigmoidf_(v1[i] + b1[i]); }
            } else if (pn == 8 || pn == 9) {
                const float sc = 0.08838834764831845f * LOG2E;
                v0 = v0 * sc; v1 = v1 * sc;
            } else {
#pragma unroll
                for (int i = 0; i < 4; ++i) { v0[i] = siluf_(v0[i]); v1[i] = siluf_(v1[i]); }
            }
            __builtin_nontemporal_store(pack8(v0, v1), (GAS u32x4*)(P + (size_t)row * PW + pc));
        } else {
            *(GAS u32x4*)(CQR + (size_t)row * 512 + (pn - 22) * 256 + col) = pack8(v0, v1);
        }
    }
};
struct FStore {
    GAS bf16_t* O; int ldc;
    __device__ __forceinline__ void operator()(const Unit& u, int row, int col, f32x4 v0, f32x4 v1) const {
        *(GAS u32x4*)(O + (size_t)row * ldc + u.pn * 256 + col) = pack8(v0, v1);
    }
};
struct FVtMem {
    GAS bf16_t* O;
    __device__ __forceinline__ void operator()(const Unit& u, int row, int col, f32x4 v0, f32x4 v1) const {
        *(GAS u32x4*)(O + ((size_t)(u.pn * 512 + row) * 256 + col)) = pack8(v0, v1);
    }
};
struct FKnope {
    GAS bf16_t* O;
    __device__ __forceinline__ void operator()(const Unit& u, int row, int col, f32x4 v0, f32x4 v1) const {
        const int c = u.pn * 256 + col;
        *(GAS u32x4*)(O + (size_t)row * 768 + (c >> 6) * 96 + (c & 63)) = pack8(v0, v1);
    }
};
struct FVt {
    GAS bf16_t* O;
    __device__ __forceinline__ void operator()(const Unit& u, int row, int col, f32x4 v0, f32x4 v1) const {
        const int b = u.pn >> 4, tl = (u.pn & 15) * 256 + col;
        *(GAS u32x4*)(O + ((size_t)(b * 512 + row) * 4096 + tl)) = pack8(v0, v1);
    }
};
struct FSsmY {
    GAS bf16_t* Y;
    __device__ __forceinline__ void operator()(const Unit& u, int row, int col, f32x4 v0, f32x4 v1) const {
        const int g = row >> 11, rowg = row & 2047, j = col >> 4, p = col & 15;
#pragma unroll
        for (int i = 0; i < 4; ++i) { v0[i] = gelu_tanh(v0[i]); v1[i] = gelu_tanh(v1[i]); }
        *(GAS u32x4*)(Y + ((size_t)(rowg * 16 + j) * 512 + g * 16 + p)) = pack8(v0, v1);
    }
};
struct FGlu {
    const GAS bf16_t* Y; GAS bf16_t* P; const GAS float* glu_b;
    __device__ __forceinline__ void operator()(const Unit& u, int row, int col, f32x4 v0, f32x4 v1) const {
        const int c = u.pn * 256 + col;
        const f32x4 b0 = *(const GAS f32x4*)(glu_b + c), b1 = *(const GAS f32x4*)(glu_b + c + 4);
        f32x4 y0, y1, z0, z1; unpack8(*(const GAS u32x4*)(Y + (size_t)row * 512 + c), y0, y1);
        GAS bf16_t* zp = P + (size_t)row * PW + PC_ZSSM + c; unpack8(*(const GAS u32x4*)zp, z0, z1);
#pragma unroll
        for (int i = 0; i < 4; ++i) { v0[i] = y0[i] * sigmoidf_(v0[i] + b0[i]) * z0[i]; v1[i] = y1[i] * sigmoidf_(v1[i] + b1[i]) * z1[i]; }
        *(GAS u32x4*)zp = pack8(v0, v1);
    }
};
struct FBranch {
    const GAS bf16_t* P; GAS bf16_t* Mg;
    __device__ __forceinline__ void operator()(const Unit& u, int row, int col, f32x4 v0, f32x4 v1) const {
        const int c = u.pn * 256 + col, seg = u.aux;
        f32x4 g0, g1; unpack8(*(const GAS u32x4*)(P + (size_t)row * PW + PC_GATE + seg * 1024 + c), g0, g1);
        GAS bf16_t* mp = Mg + (size_t)row * 1024 + c;
        v0 = v0 * g0; v1 = v1 * g1;
        if (seg != 0) { f32x4 m0, m1; unpack8(*(const GAS u32x4*)mp, m0, m1); v0 = v0 + m0; v1 = v1 + m1; }
        *(GAS u32x4*)mp = pack8(v0, v1);
    }
};
struct EpiBranchH {
    static constexpr bool PERM = true, HOOK = true;
    const GAS bf16_t* Pg; GAS bf16_t* Mgp;
    __device__ __forceinline__ void hook(f32x4 (&acc)[2][2][4][2], const Unit& u, int seg, int wr, int wc, int fr, int fq) const {
        const GAS bf16_t* gbase = Pg + (size_t)(u.pm * 256 + wr * 64 + fr) * PW + PC_GATE + (seg - 1) * 1024 + u.pn * 256 + wc * 32 + 8 * fq;
#pragma unroll
        for (int ai = 0; ai < 2; ++ai) {
            u32x4 ga[4][2], gb[4][2];
#pragma unroll
            for (int m = 0; m < 4; ++m)
#pragma unroll
                for (int bj = 0; bj < 2; ++bj) { const GAS bf16_t* gp = gbase + (size_t)(ai * 128 + m * 16) * PW + bj * 128;
                    ga[m][bj] = *(const GAS u32x4*)gp; gb[m][bj] = *(const GAS u32x4*)(gp + 1024); }
#pragma unroll
            for (int m = 0; m < 4; ++m)
#pragma unroll
                for (int bj = 0; bj < 2; ++bj) { f32x4 a0, a1, b0, b1; unpack8(ga[m][bj], a0, a1); unpack8(gb[m][bj], b0, b1);
#pragma unroll
                    for (int i = 0; i < 4; ++i) { acc[ai][bj][m][0][i] *= a0[i] * frcp(b0[i]); acc[ai][bj][m][1][i] *= a1[i] * frcp(b1[i]); } }
            asm volatile("" ::: "memory");
        }
    }
    __device__ __forceinline__ void operator()(const f32x4 (&acc)[2][2][4][2], const Unit& u, int wr, int wc, int fr, int fq) const {
#pragma unroll
        for (int ai = 0; ai < 2; ++ai)
#pragma unroll
            for (int m = 0; m < 4; ++m) {
                const int row = u.pm * 256 + ai * 128 + wr * 64 + m * 16 + fr;
#pragma unroll
                for (int bj = 0; bj < 2; ++bj) {
                    const int c = u.pn * 256 + bj * 128 + wc * 32 + 8 * fq;
                    f32x4 g0, g1; unpack8(*(const GAS u32x4*)(Pg + (size_t)row * PW + PC_GATE + 2048 + c), g0, g1);
                    *(GAS u32x4*)(Mgp + (size_t)row * 1024 + c) = pack8(acc[ai][bj][m][0] * g0, acc[ai][bj][m][1] * g1);
                }
            }
    }
};
struct EpiOutRS {
    static constexpr bool PERM = true, HOOK = false;
    GAS bf16_t* O; LAS float* rsq;
    __device__ __forceinline__ void operator()(const f32x4 (&acc)[2][2][4][2], const Unit& u, int wr, int wc, int fr, int fq) const {
#pragma unroll
        for (int ai = 0; ai < 2; ++ai)
#pragma unroll
            for (int m = 0; m < 4; ++m) {
                const int rl = ai * 128 + wr * 64 + m * 16 + fr; const size_t row = (size_t)u.pm * 256 + rl;
                float sq = 0.f;
#pragma unroll
                for (int bj = 0; bj < 2; ++bj) {
                    const f32x4 v0 = acc[ai][bj][m][0], v1 = acc[ai][bj][m][1];
                    *(GAS u32x4*)(O + row * 1024 + u.pn * 256 + bj * 128 + wc * 32 + 8 * fq) = pack8(v0, v1);
                    sq += (v0[0] * v0[0] + v0[1] * v0[1]) + (v0[2] * v0[2] + v0[3] * v0[3]) + (v1[0] * v1[0] + v1[1] * v1[1]) + (v1[2] * v1[2] + v1[3] * v1[3]);
                }
                sq += __shfl_xor(sq, 16); sq += __shfl_xor(sq, 32);
                if (fq == 0) rsq[(u.aux * 4 + wc) * 256 + rl] = sq;
            }
    }
};
struct EpiQ {
    static constexpr bool PERM = false, HOOK = false;
    GAS bf16_t* Q; const GAS float* cosT; const GAS float* sinT;
    __device__ __forceinline__ void operator()(const f32x4 (&acc)[2][2][4][2], const Unit& u, int wr, int wc, int fr, int fq) const {
        const float sc = 0.10206207261596577f * LOG2E;
#pragma unroll
        for (int ai = 0; ai < 2; ++ai)
#pragma unroll
            for (int m = 0; m < 4; ++m) {
                const int row = u.pm * 256 + ai * 128 + wr * 64 + m * 16 + fr;
#pragma unroll
                for (int bj = 0; bj < 2; ++bj) {
                    const int c0 = u.pn * 256 + bj * 128 + wc * 32;
                    f32x4 a = acc[ai][bj][m][0] * sc, b = acc[ai][bj][m][1] * sc;
                    if ((c0 % 96) == 64) {
                        const f32x4 cs = *(const GAS f32x4*)(cosT + (size_t)row * 16 + 4 * fq), sn = *(const GAS f32x4*)(sinT + (size_t)row * 16 + 4 * fq);
                        const f32x4 ra = a * cs - b * sn, rb = b * cs + a * sn; a = ra; b = rb;
                    }
                    u32x2 w0, w1; w0.x = pk2(a[0], a[1]); w0.y = pk2(a[2], a[3]); w1.x = pk2(b[0], b[1]); w1.y = pk2(b[2], b[3]);
                    GAS bf16_t* qp = Q + (size_t)row * 768 + c0 + 4 * fq;
                    *(GAS u32x2*)qp = w0; *(GAS u32x2*)(qp + 16) = w1;
                }
            }
    }
};

template <int DQK, int DV, int RH, bool NEGM>
__device__ __forceinline__ void attn_unit(LAS unsigned char* lds, const GAS bf16_t* Q, int qpitch, const GAS bf16_t* K, int kpitch,
                                          const GAS bf16_t* Vt, int vpitch, int nkv, const GAS bf16_t* ZI, GAS bf16_t* ZO, int zpitch, const int wave_) {
    constexpr int CH = DQK / 8, KCH = 64 * CH, NKL = (KCH + 511) / 512, VCH = DV * 8, NVL = VCH / 512;
    constexpr int KROWB = (DQK + 8) * 2, KBUF = 64 * KROWB, VROWB = 136, VBUF = DV * VROWB;
    int lane_ = lane_id_(); asm volatile("" : "+v"(lane_));
    const int lane = lane_, wid = wave_, tid = wave_ * 64 + lane, r32 = lane & 31, hi = lane >> 5;
    const bool grpB = false;
    LAS unsigned char* Kl = lds; LAS unsigned char* Vl = lds + 2 * KBUF;
    bf16x8 qf[RH][DQK / 16];
#pragma unroll
    for (int hh = 0; hh < RH; ++hh) { const GAS bf16_t* qp = Q + (size_t)(wid * 32 * RH + hh * 32 + r32) * qpitch + hi * 8;
#pragma unroll
      for (int d0 = 0; d0 < DQK / 16; ++d0) qf[hh][d0] = *(const GAS bf16x8*)(qp + d0 * 16); }
    u32x4 kr[NKL], vr[NVL];
#define AT_GLOAD(t) do { \
        _Pragma("unroll") for (int i_ = 0; i_ < NKL; ++i_) { const int id_ = tid + i_ * 512; if (id_ < KCH) { const int r_ = id_ / CH, c_ = id_ % CH; kr[i_] = *(const GAS u32x4*)(K + (size_t)((t) * 64 + r_) * kpitch + c_ * 8); } } \
        _Pragma("unroll") for (int i_ = 0; i_ < NVL; ++i_) { const int id_ = tid + i_ * 512; const int r_ = id_ >> 3, c_ = id_ & 7; vr[i_] = *(const GAS u32x4*)(Vt + (size_t)r_ * vpitch + (t) * 64 + c_ * 8); } } while (0)
#define AT_LSTORE(kb_, vs_) do { \
        _Pragma("unroll") for (int i_ = 0; i_ < NKL; ++i_) { const int id_ = tid + i_ * 512; if (id_ < KCH) { const int r_ = id_ / CH, c_ = id_ % CH; *(LAS u32x4*)(Kl + (kb_) * KBUF + r_ * KROWB + c_ * 16) = kr[i_]; } } \
        _Pragma("unroll") for (int i_ = 0; i_ < NVL; ++i_) { const int id_ = tid + i_ * 512; const int r_ = id_ >> 3, c_ = id_ & 7; LAS unsigned char* p_ = Vl + (vs_) * VBUF + r_ * VROWB + c_ * 16; \
            *(LAS u32x2*)p_ = (u32x2){vr[i_].x, vr[i_].y}; *(LAS u32x2*)(p_ + 8) = (u32x2){vr[i_].z, vr[i_].w}; } } while (0)
    f32x16 o[RH][DV / 32];
#pragma unroll
    for (int hh = 0; hh < RH; ++hh)
#pragma unroll
        for (int dt = 0; dt < DV / 32; ++dt)
#pragma unroll
            for (int r = 0; r < 16; ++r) o[hh][dt][r] = 0.f;
    float mref[RH], lacc[RH][4];
#pragma unroll
    for (int hh = 0; hh < RH; ++hh) { mref[hh] = 0.f; lacc[hh][0] = lacc[hh][1] = lacc[hh][2] = lacc[hh][3] = 0.f; }
    f32x16 zero16;
#pragma unroll
    for (int r = 0; r < 16; ++r) zero16[r] = 0.f;
    f32x16 negm[RH];
    float zf_ = 0.f; asm volatile("" : "+v"(zf_));
#pragma unroll
    for (int hh = 0; hh < RH; ++hh) {
#pragma unroll
        for (int r = 0; r < 16; ++r) negm[hh][r] = zf_;
        if constexpr (NEGM) asm volatile("" : "+v"(negm[hh])); }
    bf16x8 pb[RH][4];
    bf16x8 vf[NEGM ? DV / 32 : 1][4];
    bf16x8 ka_[NEGM ? DQK / 16 : 1], kb2_[NEGM ? DQK / 16 : 1];
    bool first = true;
#define AT_KLD2(d0_) do { _Pragma("unroll") for (int dd_ = (d0_); dd_ < (d0_) + 2; ++dd_) { ka_[dd_] = *(const LAS bf16x8*)(kbp_ + dd_ * 32); kb2_[dd_] = *(const LAS bf16x8*)(kbp_ + 32 * KROWB + dd_ * 32); } } while (0)
#define AT_KMM2(d0_) do { _Pragma("unroll") for (int dd_ = (d0_); dd_ < (d0_) + 2; ++dd_) _Pragma("unroll") for (int hh = 0; hh < RH; ++hh) { \
                p[hh][0] = __builtin_amdgcn_mfma_f32_32x32x16_bf16(ka_[dd_], qf[hh][dd_], dd_ == 0 ? negm[hh] : p[hh][0], 0, 0, 0); \
                p[hh][1] = __builtin_amdgcn_mfma_f32_32x32x16_bf16(kb2_[dd_], qf[hh][dd_], dd_ == 0 ? negm[hh] : p[hh][1], 0, 0, 0); } } while (0)
#define AT_QK_LD0(kb_) do { if constexpr (NEGM) { const LAS unsigned char* kbp_ = Kl + (kb_) * KBUF + r32 * KROWB + hi * 16; AT_KLD2(0); __builtin_amdgcn_sched_barrier(0); } } while (0)
#define AT_QK(kb_) do { \
        const LAS unsigned char* kbp_ = Kl + (kb_) * KBUF + r32 * KROWB + hi * 16; \
        if constexpr (NEGM) {            \
            AT_KLD2(2); AT_KMM2(0); __builtin_amdgcn_sched_barrier(0); \
            AT_KLD2(4); AT_KMM2(2); __builtin_amdgcn_sched_barrier(0); \
            AT_KMM2(4); \
        } else { \
        _Pragma("unroll") for (int d0 = 0; d0 < DQK / 16; ++d0) { \
            const bf16x8 a0 = *(const LAS bf16x8*)(kbp_ + d0 * 32), a1 = *(const LAS bf16x8*)(kbp_ + 32 * KROWB + d0 * 32); \
            _Pragma("unroll") for (int hh = 0; hh < RH; ++hh) { \
                p[hh][0] = __builtin_amdgcn_mfma_f32_32x32x16_bf16(a0, qf[hh][d0], d0 == 0 ? zero16 : p[hh][0], 0, 0, 0); \
                p[hh][1] = __builtin_amdgcn_mfma_f32_32x32x16_bf16(a1, qf[hh][d0], d0 == 0 ? zero16 : p[hh][1], 0, 0, 0); } } } } while (0)
#define AT_SOFTMAX() do { \
        _Pragma("unroll") for (int hh = 0; hh < RH; ++hh) { \
            if constexpr (!NEGM) { const float mr_ = mref[hh]; _Pragma("unroll") for (int r = 0; r < 16; ++r) { p[hh][0][r] -= mr_; p[hh][1][r] -= mr_; } } \
            float mxa = __builtin_fmaxf(p[hh][0][0], p[hh][1][0]), mxb = __builtin_fmaxf(p[hh][0][1], p[hh][1][1]), mxc = __builtin_fmaxf(p[hh][0][2], p[hh][1][2]), mxd = __builtin_fmaxf(p[hh][0][3], p[hh][1][3]); \
            _Pragma("unroll") for (int r = 4; r < 16; r += 4) { mxa = __builtin_fmaxf(__builtin_fmaxf(mxa, p[hh][0][r]), p[hh][1][r]); mxb = __builtin_fmaxf(__builtin_fmaxf(mxb, p[hh][0][r + 1]), p[hh][1][r + 1]); \
                mxc = __builtin_fmaxf(__builtin_fmaxf(mxc, p[hh][0][r + 2]), p[hh][1][r + 2]); mxd = __builtin_fmaxf(__builtin_fmaxf(mxd, p[hh][0][r + 3]), p[hh][1][r + 3]); } \
            float mx = __builtin_fmaxf(__builtin_fmaxf(mxa, mxb), __builtin_fmaxf(mxc, mxd)); \
            { auto rr_ = __builtin_amdgcn_permlane32_swap(__float_as_uint(mx), __float_as_uint(mx), false, false); mx = __builtin_fmaxf(__uint_as_float(rr_[0]), __uint_as_float(rr_[1])); } \
            if (first || __any(mx > 8.f)) {              \
                const float dl = first ? mx : __builtin_fmaxf(mx, 0.f), alpha = fexp2(-dl); \
                mref[hh] += dl; lacc[hh][0] *= alpha; lacc[hh][1] *= alpha; lacc[hh][2] *= alpha; lacc[hh][3] *= alpha; \
                if constexpr (NEGM) { _Pragma("unroll") for (int r = 0; r < 16; ++r) negm[hh][r] = -mref[hh]; asm volatile("" : "+v"(negm[hh])); } \
                _Pragma("unroll") for (int r = 0; r < 16; ++r) { p[hh][0][r] -= dl; p[hh][1][r] -= dl; } \
                _Pragma("unroll") for (int dt = 0; dt < DV / 32; ++dt) _Pragma("unroll") for (int r = 0; r < 16; ++r) o[hh][dt][r] *= alpha; \
            } \
            _Pragma("unroll") for (int r = 0; r < 16; ++r) { p[hh][0][r] = fexp2(p[hh][0][r]); p[hh][1][r] = fexp2(p[hh][1][r]); } \
            _Pragma("unroll") for (int r = 0; r < 16; r += 4) { lacc[hh][0] += p[hh][0][r] + p[hh][1][r]; lacc[hh][1] += p[hh][0][r + 1] + p[hh][1][r + 1]; lacc[hh][2] += p[hh][0][r + 2] + p[hh][1][r + 2]; lacc[hh][3] += p[hh][0][r + 3] + p[hh][1][r + 3]; } \
            u32x4 w; \
            w.x = pk2(p[hh][0][0], p[hh][0][1]); w.y = pk2(p[hh][0][2], p[hh][0][3]); w.z = pk2(p[hh][0][4], p[hh][0][5]); w.w = pk2(p[hh][0][6], p[hh][0][7]); pb[hh][0] = __builtin_bit_cast(bf16x8, w); \
            w.x = pk2(p[hh][0][8], p[hh][0][9]); w.y = pk2(p[hh][0][10], p[hh][0][11]); w.z = pk2(p[hh][0][12], p[hh][0][13]); w.w = pk2(p[hh][0][14], p[hh][0][15]); pb[hh][1] = __builtin_bit_cast(bf16x8, w); \
            w.x = pk2(p[hh][1][0], p[hh][1][1]); w.y = pk2(p[hh][1][2], p[hh][1][3]); w.z = pk2(p[hh][1][4], p[hh][1][5]); w.w = pk2(p[hh][1][6], p[hh][1][7]); pb[hh][2] = __builtin_bit_cast(bf16x8, w); \
            w.x = pk2(p[hh][1][8], p[hh][1][9]); w.y = pk2(p[hh][1][10], p[hh][1][11]); w.z = pk2(p[hh][1][12], p[hh][1][13]); w.w = pk2(p[hh][1][14], p[hh][1][15]); pb[hh][3] = __builtin_bit_cast(bf16x8, w); \
        } first = false; } while (0)
#define AT_VLOAD(vs_) do { if constexpr (NEGM) { \
        _Pragma("unroll") for (int dt = 0; dt < DV / 32; ++dt) { \
            const LAS unsigned char* vb_ = Vl + (vs_) * VBUF + (dt * 32 + r32) * VROWB + hi * 8; \
            _Pragma("unroll") for (int ks = 0; ks < 4; ++ks) { \
                const u32x2 lo_ = *(const LAS u32x2*)(vb_ + ks * 32), hh2_ = *(const LAS u32x2*)(vb_ + ks * 32 + 16); \
                const u32x4 aw_ = {lo_.x, lo_.y, hh2_.x, hh2_.y}; vf[dt][ks] = __builtin_bit_cast(bf16x8, aw_); } } \
        __builtin_amdgcn_sched_barrier(0); } } while (0)
#define AT_PV(vs_) do { if constexpr (NEGM) { \
        _Pragma("unroll") for (int ks = 0; ks < 4; ++ks) _Pragma("unroll") for (int dt = 0; dt < DV / 32; ++dt) \
            _Pragma("unroll") for (int hh = 0; hh < RH; ++hh) o[hh][dt] = __builtin_amdgcn_mfma_f32_32x32x16_bf16(vf[dt][ks], pb[hh][ks], o[hh][dt], 0, 0, 0); \
        } else { \
        _Pragma("unroll") for (int dt = 0; dt < DV / 32; ++dt) { \
            const LAS unsigned char* vb_ = Vl + (vs_) * VBUF + (dt * 32 + r32) * VROWB + hi * 8; \
            _Pragma("unroll") for (int ks = 0; ks < 4; ++ks) { \
                const u32x2 lo_ = *(const LAS u32x2*)(vb_ + ks * 32), hh2_ = *(const LAS u32x2*)(vb_ + ks * 32 + 16); \
                const u32x4 aw_ = {lo_.x, lo_.y, hh2_.x, hh2_.y}; \
                _Pragma("unroll") for (int hh = 0; hh < RH; ++hh) o[hh][dt] = __builtin_amdgcn_mfma_f32_32x32x16_bf16(__builtin_bit_cast(bf16x8, aw_), pb[hh][ks], o[hh][dt], 0, 0, 0); } } } } while (0)
    const int NT = nkv / 64;
    AT_GLOAD(0); AT_LSTORE(0, 0); __syncthreads();
    int vs_prev = 2, vs_cur = 0, vs_next = 1;
    if (!grpB) {
        for (int t = 0; t < NT; ++t) {
            const int kb = t & 1;
            if (t + 1 < NT) AT_GLOAD(t + 1);
            f32x16 p[RH][2];
            AT_QK_LD0(kb); AT_QK(kb); AT_VLOAD(vs_cur); AT_SOFTMAX(); AT_PV(vs_cur);
            if (t + 1 < NT) AT_LSTORE(kb ^ 1, vs_next);
            __syncthreads();
            vs_prev = vs_cur; vs_cur = vs_next; vs_next = (vs_next == 2) ? 0 : vs_next + 1;
        }
    } else {
        f32x16 p[RH][2];
        { if (1 < NT) AT_GLOAD(1); AT_QK_LD0(0); AT_QK(0); if (1 < NT) AT_LSTORE(1, 1); __syncthreads(); vs_prev = 0; vs_cur = 1; vs_next = 2; }
        for (int t = 1; t < NT; ++t) {
            const int kb = t & 1;
            if (t + 1 < NT) AT_GLOAD(t + 1);
            AT_VLOAD(vs_prev); AT_SOFTMAX(); AT_QK_LD0(kb); AT_PV(vs_prev); AT_QK(kb);
            if (t + 1 < NT) AT_LSTORE(kb ^ 1, vs_next);
            __syncthreads();
            vs_prev = vs_cur; vs_cur = vs_next; vs_next = (vs_next == 2) ? 0 : vs_next + 1;
        }
        AT_VLOAD(vs_prev); AT_SOFTMAX(); AT_PV(vs_prev);
    }
#undef AT_GLOAD
#undef AT_LSTORE
#undef AT_QK
#undef AT_QK_LD0
#undef AT_KLD2
#undef AT_KMM2
#undef AT_SOFTMAX
#undef AT_PV
#undef AT_VLOAD
#pragma unroll
    for (int hh = 0; hh < RH; ++hh) {
        float l = (lacc[hh][0] + lacc[hh][1]) + (lacc[hh][2] + lacc[hh][3]); l += __shfl_xor(l, 32);
        const float inv = 1.f / l;
        const size_t ro = (size_t)(wid * 32 * RH + hh * 32 + r32) * zpitch;
#pragma unroll
        for (int dt = 0; dt < DV / 32; ++dt)
#pragma unroll
            for (int i = 0; i < 4; ++i) {
                const int c = dt * 32 + 8 * i + 4 * hi;
                const u32x2 zw = *(const GAS u32x2*)(ZI + ro + c);
                u32x2 w;
                w.x = pk2(o[hh][dt][4 * i + 0] * inv * bf_lo(zw.x), o[hh][dt][4 * i + 1] * inv * bf_hi(zw.x));
                w.y = pk2(o[hh][dt][4 * i + 2] * inv * bf_lo(zw.y), o[hh][dt][4 * i + 3] * inv * bf_hi(zw.y));
                *(GAS u32x2*)(ZO + ro + c) = w;
            }
    }
    __syncthreads();
}

__device__ __forceinline__ void transpose_item(const GAS float* W, int N, int k0, int n0, GAS bf16_t* WT, int ldt, int drow0, LAS float* scr, int lane) {
    float tv[32];
#pragma unroll
    for (int i = 0; i < 32; ++i) { const int kk = 2 * i + (lane >> 5); tv[i] = __builtin_nontemporal_load(W + (size_t)(k0 + kk) * N + n0 + (lane & 31)); }
#pragma unroll
    for (int i = 0; i < 32; ++i) { const int kk = 2 * i + (lane >> 5); scr[kk * 33 + (lane & 31)] = tv[i]; }
    asm volatile("s_waitcnt lgkmcnt(0)" ::: "memory");
    const int c = lane & 7;
#pragma unroll
    for (int j = 0; j < 4; ++j) { const int n = (lane >> 3) + 8 * j; const LAS float* s = scr + (8 * c) * 33 + n;
        u32x4 o; o.x = pk2(s[0 * 33], s[1 * 33]); o.y = pk2(s[2 * 33], s[3 * 33]); o.z = pk2(s[4 * 33], s[5 * 33]); o.w = pk2(s[6 * 33], s[7 * 33]);
        *(GAS u32x4*)(WT + (size_t)(drow0 + n) * ldt + k0 + 8 * c) = o; }
    asm volatile("s_waitcnt lgkmcnt(0)" ::: "memory");
}
__device__ __forceinline__ int win_row(int n0) {
    if (n0 < 1024) return n0;
    if (n0 < 1440) return n0 - 1024 + 5632;
    if (n0 < 1952) return n0 - 1440 + 1024;
    if (n0 < 2464) return n0 - 1952 + 2048;
    if (n0 < 2976) return n0 - 2464 + 1536;
    return n0 - 2976 + 2560;
}
__device__ __forceinline__ void rms_row_1024(const GAS float* xrow, const GAS float* g, GAS bf16_t* orow, int lane) {
    const GAS f32x4* xr = (const GAS f32x4*)xrow + lane; const GAS f32x4* gr = (const GAS f32x4*)g + lane;
    f32x4 v[4]; float s = 0.f;
#pragma unroll
    for (int j = 0; j < 4; ++j) { v[j] = xr[64 * j]; s += (v[j].x * v[j].x + v[j].y * v[j].y) + (v[j].z * v[j].z + v[j].w * v[j].w); }
    const float rstd = 1.f / sqrtf(wave_sum(s) * (1.f / 1024.f) + NORM_EPS);
    GAS u32x2* o8 = (GAS u32x2*)orow + lane;
#pragma unroll
    for (int j = 0; j < 4; ++j) { const f32x4 gg = gr[64 * j]; u32x2 w; w.x = pk2(v[j].x * rstd * gg.x, v[j].y * rstd * gg.y); w.y = pk2(v[j].z * rstd * gg.z, v[j].w * rstd * gg.w); o8[64 * j] = w; }
}

__device__ __forceinline__ void rms_row2_1024(const GAS float* x0, const GAS float* x1, const GAS float* g, GAS bf16_t* o0, GAS bf16_t* o1, int lane) {
    const GAS f32x4* xr0 = (const GAS f32x4*)x0 + lane; const GAS f32x4* xr1 = (const GAS f32x4*)x1 + lane; const GAS f32x4* gr = (const GAS f32x4*)g + lane;
    f32x4 v[4], w[4]; float s = 0.f, s2 = 0.f;
#pragma unroll
    for (int j = 0; j < 4; ++j) { v[j] = __builtin_nontemporal_load(xr0 + 64 * j); w[j] = __builtin_nontemporal_load(xr1 + 64 * j); }
#pragma unroll
    for (int j = 0; j < 4; ++j) { s += (v[j].x * v[j].x + v[j].y * v[j].y) + (v[j].z * v[j].z + v[j].w * v[j].w); s2 += (w[j].x * w[j].x + w[j].y * w[j].y) + (w[j].z * w[j].z + w[j].w * w[j].w); }
#pragma unroll
    for (int o = 1; o < 64; o <<= 1) { s += __shfl_xor(s, o); s2 += __shfl_xor(s2, o); }
    const float r0 = 1.f / sqrtf(s * (1.f / 1024.f) + NORM_EPS), r1 = 1.f / sqrtf(s2 * (1.f / 1024.f) + NORM_EPS);
    GAS u32x2* p0 = (GAS u32x2*)o0 + lane; GAS u32x2* p1 = (GAS u32x2*)o1 + lane;
#pragma unroll
    for (int j = 0; j < 4; ++j) { const f32x4 gg = gr[64 * j]; u32x2 a, b;
        a.x = pk2(v[j].x * r0 * gg.x, v[j].y * r0 * gg.y); a.y = pk2(v[j].z * r0 * gg.z, v[j].w * r0 * gg.w);
        b.x = pk2(w[j].x * r1 * gg.x, w[j].y * r1 * gg.y); b.y = pk2(w[j].z * r1 * gg.z, w[j].w * r1 * gg.w);
        p0[64 * j] = a; p1[64 * j] = b; }
}


#define XB_TMO      128
#define XB_XCNT(j)  (256  + 64 * (j))
#define XB_XSUB(j)  (1280 + 64 * (j))
#define XB_XGEN(j)  (2304 + 64 * (j))
#define XB_TOP      3328
#define XB_TOPGEN   3392
#define XCD_BAR_WORDS 3456
#define XB_SPIN_CAP (1u << 18)
__device__ __forceinline__ unsigned xb_ld(unsigned* p)              { return __hip_atomic_load(p, __ATOMIC_RELAXED, __HIP_MEMORY_SCOPE_AGENT); }
__device__ __forceinline__ unsigned xb_add(unsigned* p, unsigned v) { return __hip_atomic_fetch_add(p, v, __ATOMIC_RELAXED, __HIP_MEMORY_SCOPE_AGENT); }
__device__ __forceinline__ unsigned xb_xcc_id() { return (unsigned)__builtin_amdgcn_s_getreg((3 << 11) | 20) & 0xFu; }
#define XB_SPIN(cond, bar) do { unsigned _sp = 0; while (cond) { __builtin_amdgcn_s_sleep(1); \
    if ((++_sp & 255u) == 0u) { if (xb_ld(&(bar)[XB_TMO])) break; if (_sp > XB_SPIN_CAP) { atomicAdd(&(bar)[XB_TMO], 1u); break; } } } } while (0)
struct XcdBarrier { unsigned* bar; unsigned x; volatile LAS unsigned* st; };
__device__ __forceinline__ XcdBarrier xcd_barrier_post(unsigned* bar, volatile LAS unsigned* st) {
    XcdBarrier b; b.bar = bar; b.x = xb_xcc_id(); b.st = st;
    if (threadIdx.x == 0) (void)xb_add(&bar[XB_XCNT(b.x)], 1u);
    return b;
}
__device__ __forceinline__ void xcd_barrier_complete(unsigned* bar, unsigned x, unsigned& nloc, unsigned& nx) {
    const unsigned G = gridDim.x * gridDim.y * gridDim.z;
    unsigned sum, cnt, mine, sp = 0u;
    for (;;) {
        sum = 0u; cnt = 0u; mine = 0u;
#pragma unroll
        for (unsigned j = 0; j < 16; ++j) { const unsigned c = xb_ld(&bar[XB_XCNT(j)]); sum += c; cnt += (c > 0u) ? 1u : 0u; mine = (j == x) ? c : mine; }
        if (sum == G) break;
        __builtin_amdgcn_s_sleep(1);
        if ((++sp & 255u) == 0u) { if (xb_ld(&bar[XB_TMO])) break; if (sp > XB_SPIN_CAP) { atomicAdd(&bar[XB_TMO], 1u); break; } }
    }
    nloc = mine > 0u ? mine : 1u; nx = cnt > 0u ? cnt : 1u;
}
__device__ __forceinline__ void xcd_barrier(const XcdBarrier& b, const int wave_) {
    asm volatile("s_waitcnt vmcnt(0)" ::: "memory");
    __syncthreads();
    if (wave_ == 0 && lane_id_() == 0) {
        unsigned* bar = b.bar;
        __builtin_amdgcn_s_waitcnt(0);
        unsigned nloc = b.st[0], nx = b.st[1];
        if (nloc == 0u) { xcd_barrier_complete(bar, b.x, nloc, nx); b.st[0] = nloc; b.st[1] = nx; }
        const unsigned old = xb_add(&bar[XB_XSUB(b.x)], 1u);
        const unsigned gen = old / nloc;
        if (old + 1u == (gen + 1u) * nloc) {
            __builtin_amdgcn_fence(__ATOMIC_RELEASE, "agent");
            asm volatile("s_waitcnt vmcnt(0)" ::: "memory");
            const unsigned og = xb_add(&bar[XB_TOP], 1u);
            const unsigned tg = og / nx;
            if (og + 1u == (tg + 1u) * nx) xb_add(&bar[XB_TOPGEN], 1u);
            else XB_SPIN(xb_ld(&bar[XB_TOPGEN]) == tg, bar);
            __builtin_amdgcn_fence(__ATOMIC_ACQUIRE, "agent");
            xb_add(&bar[XB_XGEN(b.x)], 1u);
            asm volatile("s_waitcnt vmcnt(0)" ::: "memory");
        } else {
            XB_SPIN(xb_ld(&bar[XB_XGEN(b.x)]) == gen, bar);
            __builtin_amdgcn_fence(__ATOMIC_ACQUIRE, "agent");
            asm volatile("s_waitcnt vmcnt(0)" ::: "memory");
        }
    }
    __syncthreads();
}

struct Args {
    const float* in[27]; float* out; unsigned char* ws; int pad0, pad1;
};
enum { I_X = 0, I_MEM, I_POS, I_PRENORM, I_WIN, I_BGATE, I_LRE, I_LIM, I_LOGDT, I_BRE, I_BIM, I_CRE, I_CIM, I_SSMD, I_GLUW, I_GLUB,
       I_QNORM, I_WQUP, I_KVNORM, I_WKVUP, I_MEMNORM, I_MEMWKV, I_WBSSM, I_WBMLA, I_WBMEM, I_WOUT, I_POSTNORM };

#ifndef PHASE_MASK
#define PHASE_MASK 0xFFFFF
#endif
#define PH(n) if constexpr ((PHASE_MASK >> (n)) & 1)
constexpr int LDS_BYTES = 147456;


__device__ __forceinline__ GAS unsigned char* launder(unsigned char* p) { asm volatile("" : "+s"(p)); return (GAS unsigned char*)p; }
__device__ __forceinline__ int opq(int v) { asm volatile("" : "+s"(v)); return v; }
#define PHASE_BASES GAS unsigned char* WSB = launder(a.ws); GAS unsigned char* DOB = launder((unsigned char*)a.out); int lane_ = lane_id_(); asm volatile("" : "+v"(lane_)); const int lane = lane_, tid = wave * 64 + lane, gtid = bx * 512 + tid; (void)lane; (void)gtid; (void)DOB; (void)WSB
#define Win_t ((GAS bf16_t*)(WSB + WS_WIN))
#define Wglu_t ((GAS bf16_t*)(WSB + WS_WGLU))
#define Wq_t ((GAS bf16_t*)(WSB + WS_WQ))
#define Wk_t ((GAS bf16_t*)(WSB + WS_WK))
#define Wv_t ((GAS bf16_t*)(WSB + WS_WV))
#define Wmk_t ((GAS bf16_t*)(WSB + WS_WMK))
#define Wmv_t ((GAS bf16_t*)(WSB + WS_WMV))
#define Wbr_t ((GAS bf16_t*)(WSB + WS_WBR))
#define Wout_t ((GAS bf16_t*)(WSB + WS_WOUT))
#define ME_t ((GAS bf16_t*)(WSB + WS_MET))
#define MY_t ((GAS bf16_t*)(WSB + WS_MYT))
#define cosT ((GAS float*)(WSB + WS_COS))
#define sinT ((GAS float*)(WSB + WS_SIN))
#define apow ((GAS float*)(WSB + WS_APOW))
#define Bbar ((GAS float*)(WSB + WS_BBAR))
#define Kt ((GAS float*)(WSB + WS_KT))
#define Kmem ((GAS bf16_t*)(WSB + WS_KMEM))
#define Vtmem ((GAS bf16_t*)(WSB + WS_VTMEM))
#define P ((GAS bf16_t*)(WSB + WS_P))
#define CQR ((GAS bf16_t*)(WSB + WS_CQR))
#define Vt ((GAS bf16_t*)(WSB + WS_VT))
#define Ap ((GAS bf16_t*)(WSB + WS_AP))
#define OUTB ((GAS bf16_t*)(WSB + WS_OUT))
#define CQN ((GAS bf16_t*)(WSB + WS_CQN))
#define CKVN ((GAS bf16_t*)(WSB + WS_CKVN))
#define H ((GAS bf16_t*)(DOB + DO_H))
#define MEMN ((GAS bf16_t*)(WSB + WS_Y))
#define Eb ((GAS bf16_t*)(DOB + DO_E))
#define Kbuf ((GAS bf16_t*)(DOB + DO_KBUF))
#define Qb ((GAS bf16_t*)(DOB + DO_QB))
#define Yb ((GAS bf16_t*)(WSB + WS_Y))
#define Mg ((GAS bf16_t*)(WSB + WS_MG))

__global__ void __launch_bounds__(512, 2) fwd_mega(Args a) {
    extern __shared__ __attribute__((aligned(16))) unsigned char lds_raw[];
    LAS unsigned char* lds = (LAS unsigned char*)lds_raw;
    cg::grid_group grid = cg::this_grid();
    volatile LAS unsigned* bar_st = (volatile LAS unsigned*)(lds + 131072 + 64);
    if (threadIdx.x < 2) bar_st[threadIdx.x] = 0u;
    __syncthreads();
    const XcdBarrier xbar = xcd_barrier_post((unsigned*)(a.ws + WS_CTL), bar_st);
    if (a.pad0 != 0) grid.sync();
    const int wave = __builtin_amdgcn_readfirstlane(threadIdx.x >> 6);
    const int G = gridDim.x, bx = blockIdx.x;
    const int vcu = (G % 8 == 0) ? (bx % 8) * (G / 8) + bx / 8 : bx;
    const int gw = vcu * 8 + wave, NGW = G * 8;
    const int NTH = G * 512;
    PH(0) {
        PHASE_BASES;
        LAS float* scr = (LAS float*)(lds + wave * 16384);
        constexpr int I0 = 16 * 189, I1 = 8 * 16, I2 = 4 * 24, I3 = 2 * 32, I4 = 16 * 32, I5 = 3 * 8 * 32, I6 = 16 * 32;
        constexpr int NIT = I0 + I1 + I2 + I3 + I4 + I5 + I6;
        for (int it = gw; it < NIT; it += NGW) {
            int r = it;
            if (r < I0) { const int kb = r / 189, nb = r % 189; transpose_item(((const GAS float*)a.in[opq(I_WIN)]), 6048, kb * 64, nb * 32, Win_t, 1024, win_row(nb * 32), scr, lane); continue; } r -= I0;
            if (r < I1) { const int kb = r / 16, nb = r % 16; transpose_item(((const GAS float*)a.in[opq(I_GLUW)]), 512, kb * 64, nb * 32, Wglu_t, 512, nb * 32, scr, lane); continue; } r -= I1;
            if (r < I2) { const int kb = r / 24, nb = r % 24; transpose_item(((const GAS float*)a.in[opq(I_WQUP)]), 768, kb * 64, nb * 32, Wq_t, 256, nb * 32, scr, lane); continue; } r -= I2;
            if (r < I3) { const int kb = r / 32, nb = r % 32, n0 = nb * 32, h = n0 >> 7, w = n0 & 127;
                if (w < 64) transpose_item(((const GAS float*)a.in[opq(I_WKVUP)]), 1024, kb * 64, n0, Wk_t, 128, h * 64 + w, scr, lane);
                else transpose_item(((const GAS float*)a.in[opq(I_WKVUP)]), 1024, kb * 64, n0, Wv_t, 128, h * 64 + w - 64, scr, lane);
                continue; } r -= I3;
            if (r < I4) { const int kb = r / 32, nb = r % 32, n0 = nb * 32;
                if (n0 < 512) transpose_item(((const GAS float*)a.in[opq(I_MEMWKV)]), 1024, kb * 64, n0, Wmk_t, 1024, n0, scr, lane);
                else transpose_item(((const GAS float*)a.in[opq(I_MEMWKV)]), 1024, kb * 64, n0, Wmv_t, 1024, n0 - 512, scr, lane);
                continue; } r -= I4;
            if (r < I5) { const int seg = r / 256, rr = r % 256, kb = rr / 32, nb = rr % 32;
                const GAS float* W = seg == 0 ? ((const GAS float*)a.in[opq(I_WBSSM)]) : (seg == 1 ? ((const GAS float*)a.in[opq(I_WBMLA)]) : ((const GAS float*)a.in[opq(I_WBMEM)]));
                transpose_item(W, 1024, kb * 64, nb * 32, Wbr_t + (size_t)seg * 512, 1536, nb * 32, scr, lane); continue; } r -= I5;
            { const int kb = r / 32, nb = r % 32; transpose_item(((const GAS float*)a.in[opq(I_WOUT)]), 1024, kb * 64, nb * 32, Wout_t, 1024, nb * 32, scr, lane); }
        }
        for (int i = gtid; i < 96 * 1024 / 8; i += NTH) *(GAS u32x4*)(Win_t + (size_t)6048 * 1024 + (size_t)i * 8) = (u32x4){0u, 0u, 0u, 0u};
        { const GAS float* xin = ((const GAS float*)a.in[opq(I_X)]); const GAS float* gin = ((const GAS float*)a.in[opq(I_PRENORM)]);
          for (int m = gw; m < TOK; m += 2 * NGW) rms_row2_1024(xin + (size_t)m * 1024, xin + (size_t)(m + NGW) * 1024, gin, H + (size_t)m * 1024, H + (size_t)(m + NGW) * 1024, lane); }
        for (int m = gw; m < 2048; m += NGW) rms_row_1024(((const GAS float*)a.in[opq(I_MEM)]) + (size_t)m * 1024, ((const GAS float*)a.in[opq(I_MEMNORM)]), MEMN + (size_t)m * 1024, lane);
        { const GAS int* pos = (const GAS int*)a.in[opq(I_POS)];
          for (int i = gtid; i < TOK * 16; i += NTH) { const int t = i >> 4, j = i & 15;
              const float invf = powf(10000.f, -(float)(2 * j) / 32.f);
              float s, c; sincos_red((double)pos[t] * (double)invf, s, c); cosT[i] = c; sinT[i] = s; } }
        for (int dg = NGW - 1 - gw; dg < 64; dg += NGW) {
            const float dt = expf(((const GAS float*)a.in[opq(I_LOGDT)])[dg]);
            const float lr = ((const GAS float*)a.in[opq(I_LRE)])[dg * 64 + lane], li = ((const GAS float*)a.in[opq(I_LIM)])[dg * 64 + lane];
            float a_re = 0.f, a_im = 0.f;
            for (int e = 0; e <= 16; ++e) {
                const float mag = expf(lr * dt * (float)e); float s, c; sincos_red((double)li * (double)dt * (double)e, s, c);
                apow[((size_t)(dg * 17 + e) * 64 + lane) * 2 + 0] = mag * c; apow[((size_t)(dg * 17 + e) * 64 + lane) * 2 + 1] = mag * s;
                if (e == 1) { a_re = mag * c; a_im = mag * s; }
            }
            const float den = lr * lr + li * li, f_re = a_re - 1.f;
            const float z_re = (f_re * lr + a_im * li) / den, z_im = (a_im * lr - f_re * li) / den;
            const GAS float* bre_ = ((const GAS float*)a.in[opq(I_BRE)]); const GAS float* bim_ = ((const GAS float*)a.in[opq(I_BIM)]);
#pragma unroll
            for (int p = 0; p < 16; ++p) {
                const float br = bre_[((size_t)dg * 64 + lane) * 16 + p], bi = bim_[((size_t)dg * 64 + lane) * 16 + p];
                Bbar[(((size_t)dg * 64 + lane) * 16 + p) * 2 + 0] = z_re * br - z_im * bi;
                Bbar[(((size_t)dg * 64 + lane) * 16 + p) * 2 + 1] = z_re * bi + z_im * br;
            }
        }
    }
    xcd_barrier(xbar, wave);

    {
      PHASE_BASES;
      PH(1) {
        const GAS float* c_re = ((const GAS float*)a.in[opq(I_CRE)]); const GAS float* c_im = ((const GAS float*)a.in[opq(I_CIM)]);
        for (int idx = gtid; idx < 64 * 16 * 256; idx += NTH) {
            const int pp = idx & 255, tau = (idx >> 8) & 15, dg = idx >> 12, p = pp >> 4, p2 = pp & 15;
            float acc = 0.f;
#pragma unroll 8
            for (int n = 0; n < 64; ++n) {
                const float wr_ = apow[((size_t)(dg * 17 + tau) * 64 + n) * 2], wi_ = apow[((size_t)(dg * 17 + tau) * 64 + n) * 2 + 1];
                const float br = Bbar[(((size_t)dg * 64 + n) * 16 + p2) * 2], bi = Bbar[(((size_t)dg * 64 + n) * 16 + p2) * 2 + 1];
                const float xr = wr_ * br - wi_ * bi, xi = wr_ * bi + wi_ * br;
                acc += c_re[((size_t)dg * 16 + p) * 64 + n] * xr - c_im[((size_t)dg * 16 + p) * 64 + n] * xi;
            }
            Kt[idx] = acc;
        }
        for (int idx = gtid; idx < 32 * 256 * 32; idx += NTH) {
            const int k8 = idx & 31, o = (idx >> 5) & 255, g = idx >> 13, j = k8 >> 1, p0 = (k8 & 1) * 8;
            const int dir = o >> 7, ri = (o >> 6) & 1, n = o & 63, dg = dir * 32 + g, e = dir ? j : 15 - j;
            const float wr_ = apow[((size_t)(dg * 17 + e) * 64 + n) * 2], wi_ = apow[((size_t)(dg * 17 + e) * 64 + n) * 2 + 1];
            float v[8];
#pragma unroll
            for (int q = 0; q < 8; ++q) { const float br = Bbar[(((size_t)dg * 64 + n) * 16 + p0 + q) * 2], bi = Bbar[(((size_t)dg * 64 + n) * 16 + p0 + q) * 2 + 1];
                v[q] = ri ? (wr_ * bi + wi_ * br) : (wr_ * br - wi_ * bi); }
            u32x4 w; w.x = pk2(v[0], v[1]); w.y = pk2(v[2], v[3]); w.z = pk2(v[4], v[5]); w.w = pk2(v[6], v[7]);
            *(GAS u32x4*)(ME_t + ((size_t)(g * 256 + o) * 256 + k8 * 8)) = w;
        }
        for (int idx = gtid; idx < 32 * 256 * 32; idx += NTH) {
            const int c8 = idx & 31, o = (idx >> 5) & 255, g = idx >> 13, j = o >> 4, p = o & 15;
            const int dir = c8 >> 4, ri = (c8 >> 3) & 1, n0 = (c8 & 7) * 8, dg = dir * 32 + g, e = dir ? 16 - j : j + 1;
            float v[8];
#pragma unroll
            for (int q = 0; q < 8; ++q) { const int n = n0 + q;
                const float wr_ = apow[((size_t)(dg * 17 + e) * 64 + n) * 2], wi_ = apow[((size_t)(dg * 17 + e) * 64 + n) * 2 + 1];
                const float cr = c_re[((size_t)dg * 16 + p) * 64 + n], ci = c_im[((size_t)dg * 16 + p) * 64 + n];
                v[q] = ri ? -(cr * wi_ + ci * wr_) : (cr * wr_ - ci * wi_); }
            u32x4 w; w.x = pk2(v[0], v[1]); w.y = pk2(v[2], v[3]); w.z = pk2(v[4], v[5]); w.w = pk2(v[6], v[7]);
            *(GAS u32x4*)(MY_t + ((size_t)(g * 256 + o) * 512 + 256 + c8 * 8)) = w;
        }
      }
        __syncthreads();
        PH(2) {
            pg8::Gemm g{H, Win_t, 1024, 1024, 1024}; pg8::SchedPlain S{TOK / 256, NPROJ / 256, G, bx, (size_t)256 * 1024 * 2, (size_t)256 * 1024 * 2};
            pg8::Epi8<FProj> E{FProj{Ap, P, CQR, ((const GAS float*)a.in[opq(I_BGATE)])}};
            pg8::gemm_phase(lds, g, S, E, wave);
        }
    }
    xcd_barrier(xbar, wave);

    {
      PHASE_BASES;
      PH(5) {
        const GAS float* qn = ((const GAS float*)a.in[opq(I_QNORM)]); const GAS float* kvn = ((const GAS float*)a.in[opq(I_KVNORM)]);
        const bool memwg = (G > 32) && (bx < 32);
        if (memwg) {
        PH(3) {
            pg8::Gemm g{MEMN, Wmk_t, 1024, 1024, 1024}; pg8::SchedPlain S{8, 2, G, bx, (size_t)256 * 1024 * 2, (size_t)256 * 1024 * 2};
            pg8::Epi8<FStore> E{FStore{Kmem, 512}};
            pg8::gemm_phase(lds, g, S, E, wave);
        }
        PH(4) {
            pg8::Gemm g{Wmv_t, MEMN, 1024, 1024, 1024}; pg8::SchedPlain S{2, 8, G, (bx + G - 16) % G, (size_t)256 * 1024 * 2, (size_t)256 * 1024 * 2};
            pg8::Epi8<FVtMem> E{FVtMem{Vtmem}};
            pg8::gemm_phase(lds, g, S, E, wave);
        }
        } else {
        const int gwr = ((G > 32) ? bx - 32 : bx) * 8 + wave, NGWR = ((G > 32) ? G - 32 : G) * 8;
        for (int t0 = gwr; t0 < TOK; t0 += 2 * NGWR) {
            const bool v1_ = t0 + NGWR < TOK;
            u32x2 wq[2]; unsigned wk[2]; float xs[2][4], xo[2][4], cs[2][4], sn[2][4];
            const int h = lane >> 3, d0 = (lane & 7) * 4;
#pragma unroll
            for (int rr = 0; rr < 2; ++rr) { const size_t t = (size_t)t0 + ((rr && v1_) ? (size_t)NGWR : 0); const GAS bf16_t* src = CQR + t * 512;
                wq[rr] = *(const GAS u32x2*)(src + lane * 4); wk[rr] = *(const GAS unsigned*)(src + 256 + lane * 2);
#pragma unroll
                for (int i = 0; i < 4; ++i) { const int d = d0 + i, dd = d & 15; xs[rr][i] = bf2f(src[384 + d]); xo[rr][i] = bf2f(src[384 + (d ^ 16)]);
                    cs[rr][i] = cosT[t * 16 + dd]; sn[rr][i] = sinT[t * 16 + dd]; } }
            const f32x4 gq = *(const GAS f32x4*)(qn + lane * 4); const float gk0 = kvn[lane * 2], gk1 = kvn[lane * 2 + 1];
            float x[2][4], y[2][2], sq[2], sk[2];
#pragma unroll
            for (int rr = 0; rr < 2; ++rr) { x[rr][0] = bf_lo(wq[rr].x); x[rr][1] = bf_hi(wq[rr].x); x[rr][2] = bf_lo(wq[rr].y); x[rr][3] = bf_hi(wq[rr].y);
                y[rr][0] = bf_lo(wk[rr]); y[rr][1] = bf_hi(wk[rr]);
                sq[rr] = x[rr][0] * x[rr][0] + x[rr][1] * x[rr][1] + x[rr][2] * x[rr][2] + x[rr][3] * x[rr][3]; sk[rr] = y[rr][0] * y[rr][0] + y[rr][1] * y[rr][1]; }
#pragma unroll
            for (int o = 1; o < 64; o <<= 1) { sq[0] += __shfl_xor(sq[0], o); sq[1] += __shfl_xor(sq[1], o); sk[0] += __shfl_xor(sk[0], o); sk[1] += __shfl_xor(sk[1], o); }
#pragma unroll
            for (int rr = 0; rr < 2; ++rr) { if (rr && !v1_) continue; const size_t t = (size_t)t0 + (size_t)rr * NGWR;
                const float rq = 1.f / sqrtf(sq[rr] * (1.f / 256.f) + NORM_EPS), rk = 1.f / sqrtf(sk[rr] * (1.f / 128.f) + NORM_EPS);
                u32x2 o; o.x = pk2(x[rr][0] * rq * gq.x, x[rr][1] * rq * gq.y); o.y = pk2(x[rr][2] * rq * gq.z, x[rr][3] * rq * gq.w);
                *(GAS u32x2*)(CQN + t * 256 + lane * 4) = o;
                *(GAS unsigned*)(CKVN + t * 128 + lane * 2) = pk2(y[rr][0] * rk * gk0, y[rr][1] * rk * gk1);
                float ov[4];
#pragma unroll
                for (int i = 0; i < 4; ++i) ov[i] = (d0 + i < 16) ? (xs[rr][i] * cs[rr][i] - xo[rr][i] * sn[rr][i]) : (xs[rr][i] * cs[rr][i] + xo[rr][i] * sn[rr][i]);
                u32x2 ok; ok.x = pk2(ov[0], ov[1]); ok.y = pk2(ov[2], ov[3]);
                *(GAS u32x2*)(Kbuf + t * 768 + h * 96 + 64 + d0) = ok; }
        }
        }
        { const GAS float* dsk = ((const GAS float*)a.in[opq(I_SSMD)]);
          for (int idx = gtid; idx < 32 * 256 * 32; idx += NTH) {
              const int k8 = idx & 31, o = (idx >> 5) & 255, g = idx >> 13, j = o >> 4, p = o & 15, j2 = k8 >> 1, q0 = (k8 & 1) * 8;
              float v[8];
#pragma unroll
              for (int q = 0; q < 8; ++q) { const int p2 = q0 + q; float x = 0.f;
                  if (j2 <= j) x += Kt[((size_t)(g * 16 + (j - j2))) * 256 + p * 16 + p2];
                  if (j2 >= j) x += Kt[((size_t)((32 + g) * 16 + (j2 - j))) * 256 + p * 16 + p2];
                  if (j2 == j && p2 == p) x += dsk[g * 16 + p];
                  v[q] = x; }
              u32x4 w; w.x = pk2(v[0], v[1]); w.y = pk2(v[2], v[3]); w.z = pk2(v[4], v[5]); w.w = pk2(v[6], v[7]);
              *(GAS u32x4*)(MY_t + ((size_t)(g * 256 + o) * 512 + k8 * 8)) = w;
          } }
      }
        PH(6) {
            pg8::Gemm g{Ap, ME_t, 512, 256, 256}; pg8::SchedBatch8 S{256, G, bx, (size_t)256 * 512 * 2, (size_t)256 * 256 * 2};
            pg8::Epi8<FStore> E{FStore{Eb, 256}};
            pg8::gemm_phase(lds, g, S, E, wave);
        }
    }
    xcd_barrier(xbar, wave);

    {
        PHASE_BASES;
        LAS float* tot = (LAS float*)lds;
        PH(7) for (int it2 = 2 * bx; it2 < 32 * 8 * 2; it2 += 2 * G) for (int it = it2; it < it2 + 2; ++it) {
            const int dir = it & 1, b = (it >> 1) & 7, g = it >> 4, dg = dir * 32 + g;
            const float aq_r = apow[((size_t)(dg * 17 + 16) * 64 + lane) * 2], aq_i = apow[((size_t)(dg * 17 + 16) * 64 + lane) * 2 + 1];
            float er[32], ei[32];
            const size_t rowbase = (size_t)g * 2048 + b * 256;
            const int c0 = dir ? 255 - wave * 32 : wave * 32; const long estr = dir ? -256 : 256, sstr = dir ? -512 : 512;
            const GAS bf16_t* ep0 = Eb + (rowbase + c0) * 256 + dir * 128 + lane;
            GAS bf16_t* sp0 = Ap + (rowbase + c0) * 512 + 256 + dir * 128 + lane;
#pragma unroll
            for (int k = 0; k < 32; ++k) { const GAS bf16_t* ep = ep0 + (long)k * estr; er[k] = bf2f(ep[0]); ei[k] = bf2f(ep[64]); }
            float sr = 0.f, si = 0.f;
#pragma unroll
            for (int k = 0; k < 32; ++k) { const float nr = aq_r * sr - aq_i * si + er[k], ni = aq_r * si + aq_i * sr + ei[k]; sr = nr; si = ni; }
            tot[(wave * 64 + lane) * 2] = sr; tot[(wave * 64 + lane) * 2 + 1] = si;
            float pr = aq_r, pi = aq_i;
#pragma unroll
            for (int s = 0; s < 5; ++s) { const float nr = pr * pr - pi * pi, ni = 2.f * pr * pi; pr = nr; pi = ni; }
            __syncthreads();
            sr = 0.f; si = 0.f;
            for (int w = 0; w < wave; ++w) { const float tr = tot[(w * 64 + lane) * 2], ti = tot[(w * 64 + lane) * 2 + 1];
                const float nr = pr * sr - pi * si + tr, ni = pr * si + pi * sr + ti; sr = nr; si = ni; }
#pragma unroll
            for (int k = 0; k < 32; ++k) { GAS bf16_t* sp = sp0 + (long)k * sstr;
                sp[0] = (bf16_t)(pk2(sr, 0.f) & 0xffffu); sp[64] = (bf16_t)(pk2(si, 0.f) & 0xffffu);
                const float nr = aq_r * sr - aq_i * si + er[k], ni = aq_r * si + aq_i * sr + ei[k]; sr = nr; si = ni; }
            __syncthreads();
        }
        asm volatile("s_waitcnt vmcnt(0)" ::: "memory"); __syncthreads();
        PH(13) {
            pg8::Gemm g{Ap, MY_t, 512, 512, 512}; pg8::SchedBatch8 S{256, G, bx, (size_t)256 * 512 * 2, (size_t)256 * 512 * 2};
            pg8::Epi8<FSsmY> E{FSsmY{Yb}};
            pg8::gemm_phase(lds, g, S, E, wave);
        }
        PH(8) {
            pg8::Gemm g{CQN, Wq_t, 256, 256, 256}; pg8::SchedPlain S{TOK / 256, 3, G, bx, (size_t)256 * 256 * 2, (size_t)256 * 256 * 2};
            EpiQ E{Qb, cosT, sinT};
            pg8::gemm_phase(lds, g, S, E, wave);
        }
        PH(9) {
            pg8::Gemm g{CKVN, Wk_t, 128, 128, 128}; pg8::SchedPlain S{TOK / 256, 2, G, bx, (size_t)256 * 128 * 2, (size_t)256 * 128 * 2};
            pg8::Epi8<FKnope> E{FKnope{Kbuf}};
            pg8::gemm_phase(lds, g, S, E, wave);
        }
        PH(10) {
            pg8::Gemm g{Wv_t, CKVN, 128, 128, 128}; pg8::SchedPlain S{2, TOK / 256, G, bx, (size_t)256 * 128 * 2, (size_t)256 * 128 * 2};
            pg8::Epi8<FVt> E{FVt{Vt}};
            pg8::gemm_phase(lds, g, S, E, wave);
        }
    }
    xcd_barrier(xbar, wave);

    {
        PHASE_BASES;
        if (wave >= 4) __builtin_amdgcn_s_setprio(1);
        PH(11) for (int L = vcu; L < 8 * 8 * 16; L += G) {
            const int qb = L & 15, bh = L >> 4, b = bh >> 3, h = bh & 7; const size_t row0 = (size_t)b * SEQ + qb * 256;
            attn_unit<96, 64, 1, true>(lds, Qb + row0 * 768 + h * 96, 768, Kbuf + (size_t)b * SEQ * 768 + h * 96, 768,
                              Vt + (size_t)(b * 512 + h * 64) * 4096, 4096, SEQ, P + row0 * PW + PC_ZMLA + h * 64, P + row0 * PW + PC_ZMLA + h * 64, PW, wave);
        }
        PH(12) for (int L = vcu; L < 8 * 4 * 16; L += G) {
            const int qb = L & 15, bh = L >> 4, b = bh >> 2, h = bh & 3; const size_t row0 = (size_t)b * SEQ + qb * 256;
            attn_unit<128, 128, 1, false>(lds, P + row0 * PW + PC_QMEM + h * 128, PW, Kmem + (size_t)b * 256 * 512 + h * 128, 512,
                                Vtmem + (size_t)(b * 512 + h * 128) * 256, 256, 256, P + row0 * PW + PC_ZMEM + h * 128, P + row0 * PW + PC_ZMEM + h * 128, PW, wave);
        }
        __builtin_amdgcn_s_setprio(0);
        PH(14) {
            pg8::Gemm g{Yb, Wglu_t, 512, 512, 512}; pg8::SchedPlain S{TOK / 256, 2, G, bx, (size_t)256 * 512 * 2, (size_t)256 * 512 * 2};
            pg8::Epi8<FGlu> E{FGlu{Yb, P, ((const GAS float*)a.in[opq(I_GLUB)])}};
            pg8::gemm_phase(lds, g, S, E, wave);
        }
    }
    xcd_barrier(xbar, wave);

    PH(15) {
        PHASE_BASES;
        pg8::Gemm g{P, Wbr_t, PW, 1536, 1536}; pg8::SchedPlain S{TOK / 256, 4, G, bx, (size_t)256 * PW * 2, (size_t)256 * 1536 * 2};
        EpiBranchH E{P, Mg};
        pg8::gemm_phase(lds, g, S, E, wave);
    }
    xcd_barrier(xbar, wave);

    if (G == 256) {
        PHASE_BASES;
        LAS float* rsq = (LAS float*)(lds + 131072 + 1024);
        LAS float* tot = rsq + 8 * 256;
        {
            pg8::Gemm g{Mg, Wout_t, 1024, 1024, 1024}; pg8::SchedPair S{bx, (size_t)256 * 1024 * 2, (size_t)256 * 1024 * 2};
            EpiOutRS E{OUTB, rsq};
            pg8::gemm_phase(lds, g, S, E, wave);
        }
        asm volatile("s_waitcnt vmcnt(0) lgkmcnt(0)" ::: "memory"); __syncthreads();
        float* xch = (float*)(a.ws + WS_CTL + 65536);
        unsigned* flg = (unsigned*)(a.ws + WS_CTL) + 3520;
        if (tid < 256) { float sv = 0.f;
#pragma unroll
            for (int k = 0; k < 8; ++k) sv += rsq[k * 256 + tid];
            tot[tid] = sv; __hip_atomic_store(xch + bx * 256 + tid, sv, __ATOMIC_RELAXED, __HIP_MEMORY_SCOPE_AGENT); }
        asm volatile("s_waitcnt vmcnt(0) lgkmcnt(0)" ::: "memory"); __syncthreads();
        if (tid == 0) {
            __hip_atomic_store(flg + bx, 1u, __ATOMIC_RELAXED, __HIP_MEMORY_SCOPE_AGENT);
            unsigned sp = 0u; while (__hip_atomic_load(flg + (bx ^ 1), __ATOMIC_RELAXED, __HIP_MEMORY_SCOPE_AGENT) == 0u) { __builtin_amdgcn_s_sleep(1); if (++sp > (1u << 22)) break; }
            __builtin_amdgcn_fence(__ATOMIC_ACQUIRE, "agent");
        }
        __syncthreads();
        if (tid < 256) { const float spv = __hip_atomic_load(xch + (bx ^ 1) * 256 + tid, __ATOMIC_RELAXED, __HIP_MEMORY_SCOPE_AGENT);
            tot[tid] = 1.f / sqrtf((tot[tid] + spv) * (1.f / 1024.f) + NORM_EPS); }
        __syncthreads();
        {
            const GAS float* x = ((const GAS float*)a.in[opq(I_X)]); const GAS float* pn = ((const GAS float*)a.in[opq(I_POSTNORM)]);
            const int cb = (bx & 1) * 512 + lane * 8; const size_t row0 = (size_t)(bx >> 1) * 256 + wave * 32;
            const f32x4 g0 = *(const GAS f32x4*)(pn + cb), g1 = *(const GAS f32x4*)(pn + cb + 4);
            for (int rr = 0; rr < 32; rr += 4) {
                u32x4 ow[4]; f32x4 x0[4], x1[4];
#pragma unroll
                for (int k = 0; k < 4; ++k) { const size_t off = (row0 + rr + k) * 1024 + cb; ow[k] = *(const GAS u32x4*)(OUTB + off);
                    x0[k] = __builtin_nontemporal_load((const GAS f32x4*)(x + off)); x1[k] = __builtin_nontemporal_load((const GAS f32x4*)(x + off + 4)); }
#pragma unroll
                for (int k = 0; k < 4; ++k) { const size_t off = (row0 + rr + k) * 1024 + cb; const float rstd = tot[wave * 32 + rr + k];
                    f32x4 lo, hi; unpack8(ow[k], lo, hi);
                    __builtin_nontemporal_store(x0[k] + lo * rstd * g0, (GAS f32x4*)(((GAS float*)a.out) + off));
                    __builtin_nontemporal_store(x1[k] + hi * rstd * g1, (GAS f32x4*)(((GAS float*)a.out) + off + 4)); }
            }
        }
    } else {
    PH(16) {
        PHASE_BASES;
        pg8::Gemm g{Mg, Wout_t, 1024, 1024, 1024}; pg8::SchedPlain S{TOK / 256, 4, G, bx, (size_t)256 * 1024 * 2, (size_t)256 * 1024 * 2};
        pg8::Epi8<FStore> E{FStore{OUTB, 1024}};
        pg8::gemm_phase(lds, g, S, E, wave);
    }
    xcd_barrier(xbar, wave);
    PH(17) {
        PHASE_BASES;
        const GAS float* x = ((const GAS float*)a.in[opq(I_X)]); const GAS float* pn = ((const GAS float*)a.in[opq(I_POSTNORM)]);
        for (int m0 = gw; m0 < TOK; m0 += 2 * NGW) {
            u32x4 ow[2][2]; f32x4 xv[2][4];
#pragma unroll
            for (int rr = 0; rr < 2; ++rr) { const size_t m = (size_t)m0 + (size_t)rr * NGW;
#pragma unroll
                for (int j = 0; j < 2; ++j) { ow[rr][j] = *(const GAS u32x4*)(OUTB + m * 1024 + j * 512 + lane * 8);
                    xv[rr][2 * j] = __builtin_nontemporal_load((const GAS f32x4*)(x + m * 1024 + j * 512 + lane * 8)); xv[rr][2 * j + 1] = __builtin_nontemporal_load((const GAS f32x4*)(x + m * 1024 + j * 512 + lane * 8 + 4)); } }
            f32x4 v[2][4]; float s[2];
#pragma unroll
            for (int rr = 0; rr < 2; ++rr) { s[rr] = 0.f;
#pragma unroll
                for (int j = 0; j < 2; ++j) { f32x4 lo, hi; unpack8(ow[rr][j], lo, hi); v[rr][2 * j] = lo; v[rr][2 * j + 1] = hi;
                    s[rr] += (lo.x * lo.x + lo.y * lo.y) + (lo.z * lo.z + lo.w * lo.w) + (hi.x * hi.x + hi.y * hi.y) + (hi.z * hi.z + hi.w * hi.w); } }
#pragma unroll
            for (int o = 1; o < 64; o <<= 1) { s[0] += __shfl_xor(s[0], o); s[1] += __shfl_xor(s[1], o); }
#pragma unroll
            for (int rr = 0; rr < 2; ++rr) { const size_t m = (size_t)m0 + (size_t)rr * NGW; const float rstd = 1.f / sqrtf(s[rr] * (1.f / 1024.f) + NORM_EPS);
#pragma unroll
                for (int q = 0; q < 4; ++q) { const int c = (q >> 1) * 512 + lane * 8 + (q & 1) * 4; const f32x4 gv = *(const GAS f32x4*)(pn + c);
                    __builtin_nontemporal_store(xv[rr][q] + v[rr][q] * rstd * gv, (GAS f32x4*)(((GAS float*)a.out) + m * 1024 + c)); } }
        }
    }
    }
}

extern "C" void kernel_launch(void* const* d_in, const int* in_sizes, int n_in, void* d_out, int out_size, void* d_ws, size_t ws_size, hipStream_t stream) {
    static int grid = 0;
    if (grid == 0) {
        if (n_in != 27 || out_size != TOK * DM || ws_size < WS_END) { fprintf(stderr, "kernel_launch: unexpected problem shape (n_in %d, out %d, ws %zu)\n", n_in, out_size, ws_size); grid = -1; return; }
        int dev = 0, cus = 0, per_cu = 0;
        hipGetDevice(&dev); hipDeviceGetAttribute(&cus, hipDeviceAttributeMultiprocessorCount, dev);
        if (hipFuncSetAttribute((const void*)fwd_mega, hipFuncAttributeMaxDynamicSharedMemorySize, LDS_BYTES) != hipSuccess) { fprintf(stderr, "hipFuncSetAttribute failed\n"); grid = -1; return; }
        if (hipOccupancyMaxActiveBlocksPerMultiprocessor(&per_cu, (const void*)fwd_mega, 512, LDS_BYTES) != hipSuccess || per_cu < 1) { fprintf(stderr, "occupancy query: %d\n", per_cu); per_cu = 1; }
        (void)hipGetLastError();
        grid = cus * 1;
    }
    if (grid < 0) return;
    if (hipMemsetAsync((char*)d_ws + WS_CTL, 0, CTL_BYTES, stream) != hipSuccess) { fprintf(stderr, "memset of barrier words failed\n"); return; }
    Args a{};
    for (int i = 0; i < 27; ++i) a.in[i] = (const float*)d_in[i];
    a.out = (float*)d_out; a.ws = (unsigned char*)d_ws;
    void* args[] = {&a};
    hipError_t e = hipLaunchCooperativeKernel((const void*)fwd_mega, dim3(grid), dim3(512), args, LDS_BYTES, stream);
    if (e != hipSuccess) fprintf(stderr, "cooperative launch failed: %s (grid %d)\n", hipGetErrorString(e), grid);
}
```
